# Optimizing an MI355X kernel written in HIP

```python
import math
import jax, jax.numpy as jnp
from jax import lax
import numpy as np

D_MODEL = 2048
BATCH = 4
SEQ = 4096
DEPTH = 4

GRID_W = 64
CTX_LEN = 256
RMS_EPS = 1e-6
NEG_INF = -1e30

BRANCH_WIDTH = D_MODEL // 4
N_BRANCHES = 4
NA_HEAD_DIM = 64
NA_HEADS = BRANCH_WIDTH // NA_HEAD_DIM
NA_WIDTH = NA_HEADS * NA_HEAD_DIM
NA_WIN_ROWS = 8
NA_WIN_COLS = 16
POOL_WIDTH = BRANCH_WIDTH
POOL_WINDOWS = (2, 4, 8, 16)
POOL_GROUPS = 4
POOL_GROUP_DIM = POOL_WIDTH // POOL_GROUPS
CONV_WIDTH = BRANCH_WIDTH
CONV_K = 3
SSM_WIDTH = BRANCH_WIDTH
SSM_GROUP_DIM = 16
SSM_GROUPS = SSM_WIDTH // SSM_GROUP_DIM
SSM_STATE = 64
SSM_DT_MIN = 1e-3
SSM_DT_MAX = 1e-1

BRANCH_TOTAL = NA_WIDTH + POOL_WIDTH + CONV_WIDTH + SSM_WIDTH
IN_LAYOUT = (
    ("na_q", NA_WIDTH), ("na_k", NA_WIDTH), ("na_v", NA_WIDTH), ("na_z", NA_WIDTH),
    ("pool_u", POOL_WIDTH), ("pool_z", POOL_WIDTH),
    ("conv_x", CONV_WIDTH), ("conv_b", CONV_WIDTH), ("conv_c", CONV_WIDTH), ("conv_z", CONV_WIDTH),
    ("ssm_u", SSM_WIDTH), ("ssm_z", SSM_WIDTH),
    ("merge", N_BRANCHES * D_MODEL),
)
IN_TOTAL = sum(size for _, size in IN_LAYOUT)

kernel_name = "hybrid_gated_mixer_dit_block"


def _in_slices():
    out, start = {}, 0
    for name, size in IN_LAYOUT:
        out[name] = (start, start + size)
        start += size
    return out


def rms_norm(x, g):
    xf = x.astype(jnp.float32)
    y = xf * lax.rsqrt(jnp.mean(xf * xf, axis=-1, keepdims=True) + RMS_EPS)
    return (y * g.astype(jnp.float32)).astype(x.dtype)


def neighbourhood_attention(q, k, v, qc, kc, vc, rpb):
    B, L, H, Dh = q.shape
    rows = L // GRID_W
    kr = min(NA_WIN_ROWS, rows)
    kcw = NA_WIN_COLS
    scale = Dh ** -0.5
    r = jnp.arange(rows)
    row_idx = jnp.clip(r - kr // 2, 0, rows - kr)[:, None] + jnp.arange(kr)[None, :]
    col = jnp.arange(GRID_W)
    col_start = jnp.clip(col - kcw // 2, 0, GRID_W - kcw)
    in_win = (col[None, :] >= col_start[:, None]) & (col[None, :] < col_start[:, None] + kcw)
    drow = row_idx - r[:, None] + (NA_WIN_ROWS - 1)
    dcol = jnp.clip(col[None, :] - col[:, None] + (NA_WIN_COLS - 1), 0, 2 * NA_WIN_COLS - 2)
    bias = rpb[:, drow[:, None, :, None], dcol[None, :, None, :]].astype(jnp.float32)
    bias = jnp.where(in_win[None, None, :, None, :], bias, NEG_INF)

    qg = q.reshape(B, rows, GRID_W, H, Dh)
    kg = k.reshape(B, rows, GRID_W, H, Dh)[:, row_idx]
    vg = v.reshape(B, rows, GRID_W, H, Dh)[:, row_idx]
    s_band = jnp.einsum('brqhd,brkwhd->bhrqkw', qg, kg,
                        preferred_element_type=jnp.float32) * scale + bias[None]
    s_ctx = jnp.einsum('brqhd,bnhd->bhrqn', qg, kc, preferred_element_type=jnp.float32) * scale
    n_band = kr * GRID_W
    s = jnp.concatenate([s_band.reshape(B, H, rows, GRID_W, n_band), s_ctx], axis=-1)
    p = jax.nn.softmax(s, axis=-1)
    p_band = p[..., :n_band].reshape(B, H, rows, GRID_W, kr, GRID_W).astype(v.dtype)
    p_ctx = p[..., n_band:].astype(v.dtype)
    o = (jnp.einsum('bhrqkw,brkwhd->brqhd', p_band, vg)
         + jnp.einsum('bhrqn,bnhd->brqhd', p_ctx, vc))
    o = o.reshape(B, L, H * Dh)
    oc = None
    if qc is not None:
        sc = jnp.einsum('bnhd,bmhd->bhnm', qc, kc, preferred_element_type=jnp.float32) * scale
        pc = jax.nn.softmax(sc, axis=-1).astype(vc.dtype)
        oc = jnp.einsum('bhnm,bmhd->bnhd', pc, vc).reshape(qc.shape[0], qc.shape[1], H * Dh)
    return o, oc


def centred_pool_minus_identity(x, window):
    B, L, C = x.shape
    xf = x.astype(jnp.float32)
    cs = jnp.concatenate([jnp.zeros((B, 1, C), jnp.float32), jnp.cumsum(xf, axis=1)], axis=1)
    t = jnp.arange(L)
    lo = jnp.clip(t - window // 2, 0, L)
    hi = jnp.clip(t + window - window // 2, 0, L)
    cnt = (hi - lo).astype(jnp.float32)[None, :, None]
    return ((cs[:, hi] - cs[:, lo]) / cnt - xf).astype(x.dtype)


def pool_branch(u, pool_w, pool_scale):
    B, L, _ = u.shape
    groups = jnp.split(u, POOL_GROUPS, axis=-1)
    pooled = jnp.stack([centred_pool_minus_identity(g, w) for g, w in zip(groups, POOL_WINDOWS)], axis=2)
    mixed = jnp.einsum('blgc,gcd->blgd', pooled, pool_w).reshape(B, L, POOL_WIDTH)
    return mixed * pool_scale


def dwconv3(x, w):
    L = x.shape[1]
    xp = jnp.pad(x, ((0, 0), (1, 1), (0, 0)))
    return xp[:, :L] * w[0] + xp[:, 1:L + 1] * w[1] + xp[:, 2:] * w[2]


def conv_branch(xv, gb, gc, conv_w):
    return gb * dwconv3(gc * xv, conv_w)


def _cmul(ar, ai, br, bi):
    return ar * br - ai * bi, ar * bi + ai * br


def s5_discretise(a_re, a_im, log_dt, b_re, b_im):
    f32 = jnp.float32
    a_re, a_im = a_re.astype(f32), a_im.astype(f32)
    dt = jnp.exp(log_dt.astype(f32))[:, None]
    mag = jnp.exp(a_re * dt)
    abar_re, abar_im = mag * jnp.cos(a_im * dt), mag * jnp.sin(a_im * dt)
    den = a_re * a_re + a_im * a_im
    num_re, num_im = abar_re - 1.0, abar_im
    f_re = (num_re * a_re + num_im * a_im) / den
    f_im = (num_im * a_re - num_re * a_im) / den
    bbar_re, bbar_im = _cmul(f_re[..., None], f_im[..., None], b_re.astype(f32), b_im.astype(f32))
    return abar_re, abar_im, bbar_re, bbar_im


def diag_scan(abar_re, abar_im, bu_re, bu_im, s0_re, s0_im, reverse):
    L = bu_re.shape[1]
    a_re = jnp.broadcast_to(abar_re, (1, L) + abar_re.shape)
    a_im = jnp.broadcast_to(abar_im, (1, L) + abar_im.shape)

    def combine(e1, e2):
        a1r, a1i, b1r, b1i = e1
        a2r, a2i, b2r, b2i = e2
        ar, ai = _cmul(a2r, a2i, a1r, a1i)
        br, bi = _cmul(a2r, a2i, b1r, b1i)
        return ar, ai, br + b2r, bi + b2i

    pr, pi, sr, si = lax.associative_scan(combine, (a_re, a_im, bu_re, bu_im), axis=1, reverse=reverse)
    if s0_re is not None:
        ir, ii = _cmul(pr, pi, s0_re[:, None], s0_im[:, None])
        sr, si = sr + ir, si + ii
    return sr, si


def s5_readout(s_re, s_im, c_re, c_im):
    B, L = s_re.shape[:2]
    y = (jnp.einsum('blgp,ghp->blgh', s_re, c_re.astype(jnp.float32))
         - jnp.einsum('blgp,ghp->blgh', s_im, c_im.astype(jnp.float32)))
    return y.reshape(B, L, SSM_WIDTH)


def s5_glu(y, glu_w, dtype):
    g = jax.nn.gelu(y).astype(dtype)
    ga, gb = jnp.split(g @ glu_w, 2, axis=-1)
    return ga * jax.nn.sigmoid(gb)


def s5_branch(u, uc, a_re, a_im, log_dt, b_re, b_im, c_re, c_im, d_skip, glu_w, with_ctx_out):
    dtype = u.dtype
    B, L, _ = u.shape
    N = uc.shape[1]
    uf, ucf = u.astype(jnp.float32), uc.astype(jnp.float32)
    ug = uf.reshape(B, L, SSM_GROUPS, SSM_GROUP_DIM)
    ucg = ucf.reshape(B, N, SSM_GROUPS, SSM_GROUP_DIM)
    dsk = d_skip.astype(jnp.float32)
    y = dsk * uf
    yc = dsk * ucf if with_ctx_out else None
    for direction, reverse in ((0, False), (1, True)):
        abr, abi, bbr, bbi = s5_discretise(a_re[direction], a_im[direction], log_dt[direction],
                                           b_re[direction], b_im[direction])
        buc_r = jnp.einsum('blgh,gph->blgp', ucg, bbr)
        buc_i = jnp.einsum('blgh,gph->blgp', ucg, bbi)
        sc_r, sc_i = diag_scan(abr, abi, buc_r, buc_i, None, None, reverse)
        last = 0 if reverse else N - 1
        bu_r = jnp.einsum('blgh,gph->blgp', ug, bbr)
        bu_i = jnp.einsum('blgh,gph->blgp', ug, bbi)
        s_r, s_i = diag_scan(abr, abi, bu_r, bu_i, sc_r[:, last], sc_i[:, last], reverse)
        y = y + s5_readout(s_r, s_i, c_re[direction], c_im[direction])
        if with_ctx_out:
            yc = yc + s5_readout(sc_r, sc_i, c_re[direction], c_im[direction])
    out = s5_glu(y, glu_w, dtype)
    outc = s5_glu(yc, glu_w, dtype) if with_ctx_out else None
    return out, outc


def gated_merge(outs, zs, gate_logits, b_gate, w_br, w_o):
    gates = jax.nn.sigmoid((gate_logits + b_gate).astype(jnp.float32)).astype(gate_logits.dtype)
    merged = None
    start = 0
    for i, (o, z) in enumerate(zip(outs, zs)):
        width = o.shape[-1]
        br = (o * jax.nn.silu(z)) @ w_br[start:start + width]
        term = gates[..., i * D_MODEL:(i + 1) * D_MODEL] * br
        merged = term if merged is None else merged + term
        start += width
    return merged @ w_o


def hybrid_mixer(h, hc, w_in, b_gate, na_rpb, pool_w, pool_scale, conv_w,
                 ssm_a_re, ssm_a_im, ssm_log_dt, ssm_b_re, ssm_b_im, ssm_c_re, ssm_c_im, ssm_d,
                 glu_w, w_br, w_o, with_ctx_out):
    sl = _in_slices()
    B, L, _ = h.shape
    N = hc.shape[1]
    proj = h @ w_in

    def part(name):
        a, b = sl[name]
        return proj[..., a:b]

    if with_ctx_out:
        projc = hc @ w_in

        def partc(name):
            a, b = sl[name]
            return projc[..., a:b]
    else:
        def partc(name):
            a, b = sl[name]
            return hc @ w_in[:, a:b]

    heads = lambda t, n: t.reshape(B if t.shape[1] == L else t.shape[0], n, NA_HEADS, NA_HEAD_DIM)
    q, k, v = heads(part("na_q"), L), heads(part("na_k"), L), heads(part("na_v"), L)
    kc, vc = heads(partc("na_k"), N), heads(partc("na_v"), N)
    qc = heads(partc("na_q"), N) if with_ctx_out else None
    o_na, oc_na = neighbourhood_attention(q, k, v, qc, kc, vc, na_rpb)

    o_pool = pool_branch(part("pool_u"), pool_w, pool_scale)
    o_conv = conv_branch(part("conv_x"), part("conv_b"), part("conv_c"), conv_w)
    o_ssm, oc_ssm = s5_branch(part("ssm_u"), partc("ssm_u"), ssm_a_re, ssm_a_im, ssm_log_dt,
                              ssm_b_re, ssm_b_im, ssm_c_re, ssm_c_im, ssm_d, glu_w, with_ctx_out)
    y = gated_merge([o_na, o_pool, o_conv, o_ssm],
                    [part("na_z"), part("pool_z"), part("conv_z"), part("ssm_z")],
                    part("merge"), b_gate, w_br, w_o)
    yc = None
    if with_ctx_out:
        oc_pool = pool_branch(partc("pool_u"), pool_w, pool_scale)
        oc_conv = conv_branch(partc("conv_x"), partc("conv_b"), partc("conv_c"), conv_w)
        yc = gated_merge([oc_na, oc_pool, oc_conv, oc_ssm],
                         [partc("na_z"), partc("pool_z"), partc("conv_z"), partc("ssm_z")],
                         partc("merge"), b_gate, w_br, w_o)
    return y, yc


def setup_inputs(seed: int = 0) -> dict:
    key = jax.random.key(seed)
    ks = jax.random.split(key, 32)
    f32 = jnp.float32

    def nrm(k, shape, std):
        return jax.random.normal(k, shape, f32) * std

    D = D_MODEL
    n_idx = jnp.arange(SSM_STATE, dtype=f32)
    sp = (DEPTH, 2, SSM_GROUPS, SSM_STATE)
    return {
        "x": nrm(ks[0], (BATCH, SEQ, D), 1.0),
        "c": nrm(ks[1], (BATCH, D), 1.0),
        "ctx": nrm(ks[2], (BATCH, CTX_LEN, D), 1.0),
        "c_ctx": nrm(ks[3], (D,), 1.0),
        "w_mod": nrm(ks[4], (DEPTH, D, 3 * D), 0.5 * D ** -0.5),
        "b_mod": nrm(ks[5], (DEPTH, 3 * D), 0.02),
        "g_pre": 1.0 + nrm(ks[6], (DEPTH, D), 0.02),
        "g_post": 1.0 + nrm(ks[7], (DEPTH, D), 0.02),
        "w_in": nrm(ks[8], (DEPTH, D, IN_TOTAL), D ** -0.5),
        "b_gate": nrm(ks[9], (DEPTH, N_BRANCHES * D), 0.02),
        "na_rpb": nrm(ks[10], (DEPTH, NA_HEADS, 2 * NA_WIN_ROWS - 1, 2 * NA_WIN_COLS - 1), 0.02),
        "pool_w": nrm(ks[11], (DEPTH, POOL_GROUPS, POOL_GROUP_DIM, POOL_GROUP_DIM), POOL_GROUP_DIM ** -0.5),
        "pool_scale": 1.0 + nrm(ks[12], (DEPTH, POOL_WIDTH), 0.02),
        "conv_w": nrm(ks[13], (DEPTH, CONV_K, CONV_WIDTH), CONV_K ** -0.5),
        "ssm_a_re": -0.5 + nrm(ks[14], sp, 0.01),
        "ssm_a_im": math.pi * n_idx + nrm(ks[15], sp, 0.01),
        "ssm_log_dt": jax.random.uniform(ks[16], (DEPTH, 2, SSM_GROUPS), f32,
                                         math.log(SSM_DT_MIN), math.log(SSM_DT_MAX)),
        "ssm_b_re": nrm(ks[17], sp + (SSM_GROUP_DIM,), (2 * SSM_GROUP_DIM) ** -0.5),
        "ssm_b_im": nrm(ks[18], sp + (SSM_GROUP_DIM,), (2 * SSM_GROUP_DIM) ** -0.5),
        "ssm_c_re": nrm(ks[19], (DEPTH, 2, SSM_GROUPS, SSM_GROUP_DIM, SSM_STATE), SSM_STATE ** -0.5),
        "ssm_c_im": nrm(ks[20], (DEPTH, 2, SSM_GROUPS, SSM_GROUP_DIM, SSM_STATE), SSM_STATE ** -0.5),
        "ssm_d": nrm(ks[21], (DEPTH, SSM_WIDTH), 1.0),
        "glu_w": nrm(ks[22], (DEPTH, SSM_WIDTH, 2 * SSM_WIDTH), SSM_WIDTH ** -0.5),
        "w_br": nrm(ks[23], (DEPTH, BRANCH_TOTAL, D), BRANCH_WIDTH ** -0.5),
        "w_o": nrm(ks[24], (DEPTH, D, D), D ** -0.5),
    }


def reference(x, c, ctx, c_ctx, w_mod, b_mod, g_pre, g_post, w_in, b_gate, na_rpb, pool_w,
              pool_scale, conv_w, ssm_a_re, ssm_a_im, ssm_log_dt, ssm_b_re, ssm_b_im,
              ssm_c_re, ssm_c_im, ssm_d, glu_w, w_br, w_o):
    c_act = jax.nn.silu(c)
    cc_act = jax.nn.silu(c_ctx)
    xc = ctx
    for i in range(DEPTH):
        with_ctx_out = i < DEPTH - 1
        shift, scale, gate = jnp.split(c_act @ w_mod[i] + b_mod[i], 3, axis=-1)
        shift_c, scale_c, gate_c = jnp.split(cc_act @ w_mod[i] + b_mod[i], 3, axis=-1)
        h = rms_norm(x, g_pre[i]) * (1.0 + scale[:, None]) + shift[:, None]
        hc = rms_norm(xc, g_pre[i]) * (1.0 + scale_c) + shift_c
        y, yc = hybrid_mixer(h, hc, w_in[i], b_gate[i], na_rpb[i], pool_w[i], pool_scale[i], conv_w[i],
                             ssm_a_re[i], ssm_a_im[i], ssm_log_dt[i], ssm_b_re[i], ssm_b_im[i],
                             ssm_c_re[i], ssm_c_im[i], ssm_d[i], glu_w[i], w_br[i], w_o[i], with_ctx_out)
        x = x + gate[:, None] * rms_norm(y, g_post[i])
        if with_ctx_out:
            xc = xc + gate_c * rms_norm(yc, g_post[i])
    return x
```

```cpp
#include <hip/hip_runtime.h>
#include <hip/hip_cooperative_groups.h>
#include <cstdio>
namespace cg = cooperative_groups;

#ifndef MULTI_LAUNCH
#define MULTI_LAUNCH 0
#endif

#define LAS __attribute__((address_space(3)))
typedef unsigned short bf16_t;
typedef short bf16x8 __attribute__((ext_vector_type(8)));
typedef float f32x4 __attribute__((ext_vector_type(4)));
typedef unsigned u32x4 __attribute__((ext_vector_type(4)));

constexpr int DM = 2048, NBATCH = 4, SEQ = 4096, NCTX = 256;
constexpr int TLAT = NBATCH * SEQ, TCTX = NBATCH * NCTX, T = TLAT + TCTX;
constexpr int NIN = 14336;
constexpr int NCHUNK = T / 16;
constexpr int XROWS = 1280;
constexpr int LDS_BYTES = 131072 + 16;

constexpr size_t WS_WINT = 0;
constexpr size_t WS_WBRT = WS_WINT + (size_t)4 * NIN * DM * 2;
constexpr size_t WS_WOT  = WS_WBRT + (size_t)4 * DM * DM * 2;
constexpr size_t WS_GLUT = WS_WOT + (size_t)4 * DM * DM * 2;
constexpr size_t WS_MG   = WS_GLUT + (size_t)4 * 1024 * 512 * 2;
constexpr size_t WS_WG   = WS_MG + (size_t)4 * 32 * 256 * 512 * 2;
constexpr size_t WS_A16  = WS_WG + (size_t)4 * 32 * 256 * 256 * 2;
constexpr size_t WS_MOD  = WS_A16 + (size_t)4 * 2 * 32 * 64 * 2 * 4;
constexpr size_t WS_H    = WS_MOD + (size_t)4 * 5 * 6144 * 4;
constexpr size_t WS_PROJ = WS_H + (size_t)T * DM * 2;
constexpr size_t WS_VT   = WS_PROJ + (size_t)T * NIN * 2;
constexpr size_t WS_X    = WS_VT + (size_t)512 * T * 2;
constexpr size_t WS_E    = WS_X + (size_t)32 * XROWS * 512 * 2;
constexpr size_t WS_G    = WS_E + (size_t)32 * XROWS * 256 * 4;
constexpr size_t WS_U    = WS_G + (size_t)T * 512 * 2;
constexpr size_t WS_MRG  = WS_U + (size_t)T * DM * 2;
constexpr size_t WS_Y    = WS_MRG + (size_t)T * DM * 2;
constexpr size_t WS_XC   = WS_Y + (size_t)T * DM * 4;
constexpr size_t WS_BAR  = WS_XC + (size_t)TCTX * DM * 4;
constexpr size_t WS_R    = WS_BAR + 16384;
constexpr size_t WS_END  = WS_R + (size_t)4 * T * DM * 2;

struct Params {
    const float *x, *c, *ctx, *c_ctx, *w_mod, *b_mod, *g_pre, *g_post, *w_in, *b_gate, *na_rpb, *pool_w, *pool_scale, *conv_w,
        *a_re, *a_im, *log_dt, *b_re, *b_im, *c_re, *c_im, *ssm_d, *glu_w, *w_br, *w_o;
    float* out; unsigned char* ws; int ph_lo, ph_hi;
};

typedef const __attribute__((address_space(4))) Params* PP;

typedef float f32x2_t __attribute__((ext_vector_type(2)));
typedef __bf16 bf16x2_t __attribute__((ext_vector_type(2)));
__device__ __forceinline__ unsigned cvt_pk_bf16(float lo, float hi) { const f32x2_t f = {lo, hi}; const bf16x2_t b = __builtin_convertvector(f, bf16x2_t); unsigned r; __builtin_memcpy(&r, &b, 4); return r; }
__device__ __forceinline__ bf16_t f2bf(float f) { unsigned u = __float_as_uint(f); u += 0x7FFFu + ((u >> 16) & 1u); return (bf16_t)(u >> 16); }
__device__ __forceinline__ float bf2f(bf16_t b) { return __uint_as_float(((unsigned)b) << 16); }
__device__ __forceinline__ float bflo(unsigned w) { return __uint_as_float(w << 16); }
__device__ __forceinline__ float bfhi(unsigned w) { return __uint_as_float(w & 0xFFFF0000u); }
__device__ __forceinline__ float sigmoidf_(float x) { return __builtin_amdgcn_rcpf(1.0f + __builtin_amdgcn_exp2f(-1.4426950408889634f * x)); }
__device__ __forceinline__ float siluf_(float x) { return x * sigmoidf_(x); }
__device__ __forceinline__ float gelu_tanh(float y) { const float u = 0.7978845608028654f * (y + 0.044715f * y * y * y); return y * sigmoidf_(2.0f * u); }
__device__ __forceinline__ void unpack8(const u32x4 w, float (&f)[8]) { f[0] = bflo(w.x); f[1] = bfhi(w.x); f[2] = bflo(w.y); f[3] = bfhi(w.y); f[4] = bflo(w.z); f[5] = bfhi(w.z); f[6] = bflo(w.w); f[7] = bfhi(w.w); }
__device__ __forceinline__ u32x4 pack8(const float (&f)[8]) { u32x4 w; w.x = cvt_pk_bf16(f[0], f[1]); w.y = cvt_pk_bf16(f[2], f[3]); w.z = cvt_pk_bf16(f[4], f[5]); w.w = cvt_pk_bf16(f[6], f[7]); return w; }

__device__ __forceinline__ int opaque_tid() { int t = threadIdx.x; asm volatile("" : "+v"(t)); return t; }

namespace pg8 {
constexpr int BM = 256, BK = 64, HALF = 128, HTB = HALF * BK * 2, STAGE_BYTES = 8 * HTB, NXCD = 8, WGM = 4;
__device__ __forceinline__ int lds_byte(int r, int c) { const int st = (r >> 4) * 2 + (c >> 5), rr = r & 15, cc = c & 31, ob = rr * 64 + cc * 2; return st * 1024 + (ob ^ (((ob >> 9) & 1) << 5)); }
__device__ __forceinline__ void stage_rc(int b, int& R, int& C) { const int st = b / 1024, sb = b % 1024, swz = sb ^ (((sb >> 9) & 1) << 5); R = (st >> 1) * 16 + swz / 64; C = (st & 1) * 32 + (swz % 64) / 2; }
__device__ __forceinline__ int perm32(int rho) { const int n = rho >> 4, i = rho & 15; return 8 * (i >> 2) + 4 * n + (i & 3); }

struct Unit { const char* a; const char* b; int pm, pn, kind; };
struct Gemm { int lda, ldb, K; };

__device__ __forceinline__ void swz_tile(int L, int nM, int nN, int& pm, int& pn) {
    const int nwg = nM * nN; int wgid = L;
    { const int q = nwg / NXCD, r = nwg % NXCD, xcd = wgid % NXCD, off = wgid / NXCD; wgid = (xcd < r ? xcd * (q + 1) : r * (q + 1) + (xcd - r) * q) + off; }
    const int nig = WGM * nN, gid = wgid / nig, fm = gid * WGM, gsz = (nM - fm) < WGM ? (nM - fm) : WGM;
    pm = fm + ((wgid % nig) % gsz); pn = (wgid % nig) / gsz;
}

template <class Epi, class Sched>
__device__ __forceinline__ void gemm_phase(LAS unsigned char* lds, const Gemm g, const Sched& S, const Epi& E) {
    const int tid = opaque_tid(), wid = __builtin_amdgcn_readfirstlane(tid >> 6), lane = tid & 63, wr = wid >> 2, wc = wid & 3, fr = lane & 15, fq = lane >> 4;
    int K = g.K; asm volatile("" : "+s"(K)); const int nt = K / BK;
    unsigned voffA[2], voffB[2];
#pragma unroll
    for (int i = 0; i < 2; ++i) { int R, C; stage_rc(tid * 16 + i * 8192, R, C); const int Rb = Epi::PERM ? ((R & ~31) + perm32(R & 31)) : R;
        voffA[i] = (unsigned)(R * g.lda + C) * 2u; voffB[i] = (unsigned)(Rb * g.ldb + C) * 2u; }
    const size_t kstep = (size_t)(BK * 2);
    const size_t hstepA = (size_t)HALF * g.lda * 2, hstepB = (size_t)HALF * g.ldb * 2;
    const unsigned ldsw = (unsigned)wid * 1024u;
    const int aoff = lds_byte(wr * 64 + fr, fq * 8), boff = lds_byte(wc * 32 + fr, fq * 8);
#define PG8_SA(b, h) (((b) * 2 + (h)) * HTB)
#define PG8_SB(b, h) ((4 + (b) * 2 + (h)) * HTB)
#define PG8_STAGE(bufoff, gbase, voff) do { _Pragma("unroll") for (int _i = 0; _i < 2; ++_i) \
        __builtin_amdgcn_global_load_lds((const unsigned*)((const char*)(gbase) + (voff)[_i]), (LAS unsigned*)(lds + (bufoff) + ldsw + _i * 8192), 16, 0, 0); } while (0)
#define PG8_LDA(dst, b, h) do { _Pragma("unroll") for (int m = 0; m < 4; ++m) _Pragma("unroll") for (int k = 0; k < 2; ++k) dst[m][k] = *(const LAS bf16x8*)(lds + PG8_SA(b, h) + aoff + m * 2048 + k * 1024); } while (0)
#define PG8_LDB(dst, b, h) do { _Pragma("unroll") for (int n = 0; n < 2; ++n) _Pragma("unroll") for (int k = 0; k < 2; ++k) dst[n][k] = *(const LAS bf16x8*)(lds + PG8_SB(b, h) + boff + n * 2048 + k * 1024); } while (0)
#define PG8_MMA(ai, bj, At, Bt) do { __builtin_amdgcn_s_setprio(1); _Pragma("unroll") for (int m = 0; m < 4; ++m) _Pragma("unroll") for (int n = 0; n < 2; ++n) _Pragma("unroll") for (int k = 0; k < 2; ++k) \
        acc[ai][bj][m][n] = __builtin_amdgcn_mfma_f32_16x16x32_bf16(Bt[n][k], At[m][k], acc[ai][bj][m][n], 0, 0, 0); __builtin_amdgcn_s_setprio(0); } while (0)
#ifdef SAFE_WAITS
#define PG8_WAIT_V(n) asm volatile("s_waitcnt vmcnt(0)" ::: "memory")
#else
#define PG8_WAIT_V(n) asm volatile("s_waitcnt vmcnt(" #n ")" ::: "memory")
#endif
#ifdef SAFE_WAITS
#define PG8_WAIT_L(n) asm volatile("s_waitcnt lgkmcnt(0)" ::: "memory")
#else
#define PG8_WAIT_L(n) asm volatile("s_waitcnt lgkmcnt(" #n ")" ::: "memory")
#endif
#define PG8_BAR do { __builtin_amdgcn_sched_barrier(0); __builtin_amdgcn_s_barrier(); __builtin_amdgcn_sched_barrier(0); } while (0)
#define PG8_SCHED __builtin_amdgcn_sched_barrier(0)
    Unit cur, nxt; int ui = 0;
    if (!S.next(0, cur)) return;
    f32x4 acc[2][2][4][2];
#pragma unroll
    for (int a = 0; a < 2; ++a)
#pragma unroll
        for (int b = 0; b < 2; ++b)
#pragma unroll
            for (int m = 0; m < 4; ++m)
#pragma unroll
                for (int n = 0; n < 2; ++n) acc[a][b][m][n] = (f32x4){0.f, 0.f, 0.f, 0.f};
    bf16x8 At[4][2], B0[2][2], B1[2][2];
#ifdef SYNC_GEMM
    const char* cA = cur.a; const char* cB = cur.b;
    for (;;) {
        const bool has_next = S.next(ui + 1, nxt);
        for (int t = 0; t < nt; ++t) {
            if constexpr (Epi::SEG) { if (t != 0 && (t & 7) == 0) E.segment(acc, cur, t >> 3, wr, wc, fr, fq); }
            const char* at = cA + (size_t)t * kstep; const char* bt = cB + (size_t)t * kstep;
            PG8_BAR;
            PG8_STAGE(PG8_SB(0, 0), bt, voffB); PG8_STAGE(PG8_SA(0, 0), at, voffA); PG8_STAGE(PG8_SB(0, 1), bt + hstepB, voffB); PG8_STAGE(PG8_SA(0, 1), at + hstepA, voffA);
            PG8_WAIT_V(0); PG8_BAR;
            PG8_LDB(B0, 0, 0); PG8_LDB(B1, 0, 1); PG8_LDA(At, 0, 0); PG8_WAIT_L(0); PG8_MMA(0, 0, At, B0); PG8_MMA(0, 1, At, B1);
            PG8_LDA(At, 0, 1); PG8_WAIT_L(0); PG8_MMA(1, 0, At, B0); PG8_MMA(1, 1, At, B1);
        }
        E(acc, cur, wr, wc, fr, fq);
        if (!has_next) break;
#pragma unroll
        for (int a = 0; a < 2; ++a)
#pragma unroll
            for (int b = 0; b < 2; ++b)
#pragma unroll
                for (int m = 0; m < 4; ++m)
#pragma unroll
                    for (int n = 0; n < 2; ++n) acc[a][b][m][n] = (f32x4){0.f, 0.f, 0.f, 0.f};
        cur = nxt; cA = cur.a; cB = cur.b; ++ui;
    }
    PG8_WAIT_V(0);
    PG8_BAR;
#else
    const char* cA = cur.a; const char* cB = cur.b;
    PG8_STAGE(PG8_SB(0, 0), cB, voffB); PG8_STAGE(PG8_SA(0, 0), cA, voffA); PG8_STAGE(PG8_SB(0, 1), cB + hstepB, voffB); PG8_STAGE(PG8_SA(0, 1), cA + hstepA, voffA);
    if (wr == 1) PG8_BAR;
    PG8_WAIT_V(4); PG8_BAR;
    PG8_STAGE(PG8_SB(1, 0), cB + kstep, voffB); PG8_STAGE(PG8_SA(1, 0), cA + kstep, voffA); PG8_STAGE(PG8_SB(1, 1), cB + hstepB + kstep, voffB);
    PG8_WAIT_V(6); PG8_BAR;
    for (;;) {
        const bool has_next = S.next(ui + 1, nxt);
        const char* nA = has_next ? nxt.a : cA; const char* nB = has_next ? nxt.b : cB;
        for (int t = 0; t < nt; t += 2) {
            const bool last = (t == nt - 2);
            if constexpr (Epi::SEG) { if (t != 0 && (t & 7) == 0) E.segment(acc, cur, t >> 3, wr, wc, fr, fq); }
            const char* a1 = cA + (size_t)(t + 1) * kstep;
            const char* a2 = last ? nA : cA + (size_t)(t + 2) * kstep; const char* b2 = last ? nB : cB + (size_t)(t + 2) * kstep;
            const char* a3 = a2 + kstep; const char* b3 = b2 + kstep;
            PG8_LDB(B0, 0, 0); PG8_SCHED; PG8_LDA(At, 0, 0); PG8_STAGE(PG8_SA(1, 1), a1 + hstepA, voffA);
            PG8_WAIT_L(8); PG8_BAR; PG8_WAIT_L(0); PG8_MMA(0, 0, At, B0); PG8_BAR; PG8_SCHED;
            PG8_LDB(B1, 0, 1); PG8_STAGE(PG8_SB(0, 0), b2, voffB);
            PG8_BAR; PG8_WAIT_L(0); PG8_MMA(0, 1, At, B1); PG8_BAR;
            PG8_LDA(At, 0, 1); PG8_STAGE(PG8_SA(0, 0), a2, voffA);
            PG8_BAR; PG8_WAIT_L(0); PG8_MMA(1, 0, At, B0); PG8_BAR; PG8_SCHED;
            PG8_STAGE(PG8_SB(0, 1), b2 + hstepB, voffB);
            PG8_WAIT_V(6); PG8_BAR; PG8_MMA(1, 1, At, B1); PG8_BAR;
            PG8_LDB(B0, 1, 0); PG8_SCHED; PG8_LDA(At, 1, 0); PG8_STAGE(PG8_SA(0, 1), a2 + hstepA, voffA);
            PG8_WAIT_L(8); PG8_BAR; PG8_WAIT_L(0); PG8_MMA(0, 0, At, B0); PG8_BAR; PG8_SCHED;
            PG8_LDB(B1, 1, 1); PG8_STAGE(PG8_SB(1, 0), b3, voffB);
            PG8_BAR; PG8_WAIT_L(0); PG8_MMA(0, 1, At, B1); PG8_BAR;
            PG8_LDA(At, 1, 1); PG8_STAGE(PG8_SA(1, 0), a3, voffA);
            PG8_BAR; PG8_WAIT_L(0); PG8_MMA(1, 0, At, B0); PG8_BAR; PG8_SCHED;
            PG8_STAGE(PG8_SB(1, 1), b3 + hstepB, voffB);
            PG8_WAIT_V(6); PG8_BAR; PG8_MMA(1, 1, At, B1); PG8_BAR;
        }
        E(acc, cur, wr, wc, fr, fq);
        if (!has_next) break;
#pragma unroll
        for (int a = 0; a < 2; ++a)
#pragma unroll
            for (int b = 0; b < 2; ++b)
#pragma unroll
                for (int m = 0; m < 4; ++m)
#pragma unroll
                    for (int n = 0; n < 2; ++n) acc[a][b][m][n] = (f32x4){0.f, 0.f, 0.f, 0.f};
        cur = nxt; cA = nA; cB = nB; ++ui;
    }
    PG8_WAIT_V(0);
    if (wr == 0) PG8_BAR;
    PG8_BAR;
#endif
#undef PG8_SA
#undef PG8_SB
#undef PG8_STAGE
#undef PG8_LDA
#undef PG8_LDB
#undef PG8_MMA
#undef PG8_WAIT_V
#undef PG8_WAIT_L
#undef PG8_BAR
#undef PG8_SCHED
}
}
using pg8::Unit;
typedef f32x4 Acc[2][2][4][2];

struct OrderInproj {
    const char* W; const char* H; int G, c;
    __device__ __forceinline__ bool next(int i, Unit& u) const {
        const int L = i * G + c; constexpr int NMAIN = 68 * 54;
        if (L >= NMAIN + 136) return false;
        if (L < NMAIN) { int pm, pn; pg8::swz_tile(L, 68, 54, pm, pn); if (pn >= 4) pn += 2;
            u.a = H + (size_t)pm * 256 * DM * 2; u.b = W + (size_t)pn * 256 * DM * 2; u.pm = pm; u.pn = pn; u.kind = 0; }
        else { const int v = L - NMAIN, pm = v & 1, pn = v >> 1;
            u.a = W + (size_t)(1024 + pm * 256) * DM * 2; u.b = H + (size_t)pn * 256 * DM * 2; u.pm = pm; u.pn = pn; u.kind = 1; }
        return true;
    }
};
struct OrderSimple {
    const char* A; const char* B; int nM, nN, lda, ldb, G, c;
    __device__ __forceinline__ bool next(int i, Unit& u) const {
        const int L = i * G + c; if (L >= nM * nN) return false;
        int pm, pn; pg8::swz_tile(L, nM, nN, pm, pn);
        u.a = A + (size_t)pm * 256 * lda * 2; u.b = B + (size_t)pn * 256 * ldb * 2; u.pm = pm; u.pn = pn; u.kind = 0; return true;
    }
};
struct OrderGroup {
    const char* X; const char* Mt; int ldb, G, c;
    __device__ __forceinline__ bool next(int i, Unit& u) const {
        const int L = i * G + c; if (L >= 160) return false;
        const int g = L / 5, r = L - g * 5;
        u.a = X + ((size_t)(g * XROWS + r * 256) * 512) * 2; u.b = Mt + (size_t)g * 256 * ldb * 2; u.pm = r; u.pn = g; u.kind = 0; return true;
    }
};

struct EpiInproj {
    static constexpr bool PERM = true, SEG = false;
    bf16_t* proj; bf16_t* vt; bf16_t* X; const float* bgate; bf16_t* R;
    __device__ __forceinline__ void operator()(const Acc& acc, const Unit& u, int wr, int wc, int fr, int fq) const {
        const int row0 = u.pm * 256 + wr * 64 + fr, col0 = u.pn * 256 + wc * 32 + 8 * fq;
        if (u.kind == 1) {
#pragma unroll
            for (int ai = 0; ai < 2; ++ai)
#pragma unroll
                for (int m = 0; m < 4; ++m) { bf16_t* rowp = vt + (size_t)(row0 + ai * 128 + m * 16) * T + col0;
#pragma unroll
                    for (int bj = 0; bj < 2; ++bj) { const f32x4 v0 = acc[ai][bj][m][0], v1 = acc[ai][bj][m][1]; u32x4 w;
                        w.x = cvt_pk_bf16(v0[0], v0[1]); w.y = cvt_pk_bf16(v0[2], v0[3]); w.z = cvt_pk_bf16(v1[0], v1[1]); w.w = cvt_pk_bf16(v1[2], v1[3]);
                        *(u32x4*)(rowp + bj * 128) = w; } }
            return;
        }
        const int pn = u.pn;
        if (pn >= 24) {
            const int ch0 = (pn - 24) * 64 + wc * 16 + fq * 4;
            f32x4 bgv[4];
#pragma unroll
            for (int br = 0; br < 4; ++br) bgv[br] = *(const f32x4*)(bgate + br * DM + ch0);
#pragma unroll
            for (int ai = 0; ai < 2; ++ai)
#pragma unroll
                for (int m = 0; m < 4; ++m) { const int row = row0 + ai * 128 + m * 16; f32x4 g[4], d[4];
                    const int cl = ch0 & 255, rl = row & 255;
                    const size_t roff = ((((((size_t)((row >> 8) * 8 + (ch0 >> 8)) * 2 + (rl >> 7)) * 4 + ((rl >> 4) & 3)) * 2 + (cl >> 7)) * 8 + (((rl >> 6) & 1) * 4 + ((cl >> 5) & 3))) * 64
                                         + ((rl & 15) + 16 * ((cl >> 3) & 3))) * 8 + (cl & 7);
#pragma unroll
                    for (int br = 0; br < 4; ++br)
#pragma unroll
                        for (int j = 0; j < 4; ++j) { d[br][j] = fminf(1.0f + __builtin_amdgcn_exp2f(-1.4426950408889634f * (acc[ai][br >> 1][m][br & 1][j] + bgv[br][j])), 1e30f); g[br][j] = __builtin_amdgcn_rcpf(d[br][j]); }
#pragma unroll
                    for (int k = 0; k < 4; ++k) { f32x4 r = g[k];
                        if (k < 3) {
#pragma unroll
                            for (int j = 0; j < 4; ++j) r[j] = g[k][j] * d[k + 1][j]; }
                        uint2 w; w.x = cvt_pk_bf16(r[0], r[1]); w.y = cvt_pk_bf16(r[2], r[3]);
                        *(uint2*)(R + (size_t)k * T * DM + roff) = w; } }
            return;
        }
        int mode = 0;
        if (pn < 2) mode = 1; else if (pn == 6 || pn == 7 || pn == 10 || pn == 11 || pn == 18 || pn == 19 || pn == 22 || pn == 23) mode = 2;
        else if (pn == 20 || pn == 21) mode = 3; else if (pn >= 24) mode = 4;
#pragma unroll
        for (int bj = 0; bj < 2; ++bj) {
            const int col = col0 + bj * 128;
            float bg[8];
#pragma unroll
            for (int e = 0; e < 8; ++e) bg[e] = 0.f;
            if (mode == 4) { const f32x4 b0 = *(const f32x4*)(bgate + col - 6144), b1 = *(const f32x4*)(bgate + col - 6144 + 4);
#pragma unroll
                for (int e = 0; e < 4; ++e) { bg[e] = b0[e]; bg[4 + e] = b1[e]; } }
#pragma unroll
            for (int ai = 0; ai < 2; ++ai)
#pragma unroll
                for (int m = 0; m < 4; ++m) {
                    const int row = row0 + ai * 128 + m * 16;
                    float v[8];
#pragma unroll
                    for (int e = 0; e < 4; ++e) { v[e] = acc[ai][bj][m][0][e]; v[4 + e] = acc[ai][bj][m][1][e]; }
                    if (mode == 1) {
#pragma unroll
                        for (int e = 0; e < 8; ++e) v[e] *= 0.125f;
                    } else if (mode == 2) {
#pragma unroll
                        for (int e = 0; e < 8; ++e) v[e] = siluf_(v[e]);
                    } else if (mode == 4) {
#pragma unroll
                        for (int e = 0; e < 8; ++e) v[e] = sigmoidf_(v[e] + bg[e]);
                    }
                    const u32x4 w = pack8(v);
                    if (mode == 3) { const int cc = col - 5120, g = cc >> 4, h0 = cc & 15, n = row >> 4, j = row & 15;
                        *(u32x4*)(X + ((size_t)(g * XROWS + n) * 512 + j * 16 + h0)) = w; }
                    else *(u32x4*)(proj + (size_t)row * NIN + col) = w;
                }
        }
    }
};
struct EpiE {
    static constexpr bool PERM = false, SEG = false;
    float* E;
    __device__ __forceinline__ void operator()(const Acc& acc, const Unit& u, int wr, int wc, int fr, int fq) const {
        const int g = u.pn, row0 = u.pm * 256 + wr * 64 + fr, col0 = wc * 32 + 4 * fq;
#pragma unroll
        for (int ai = 0; ai < 2; ++ai)
#pragma unroll
            for (int m = 0; m < 4; ++m) { const int n = row0 + ai * 128 + m * 16; if (n < NCHUNK) { float* rowp = E + (size_t)(g * XROWS + n) * 256 + col0;
#pragma unroll
                for (int bj = 0; bj < 2; ++bj)
#pragma unroll
                    for (int nn = 0; nn < 2; ++nn) *(f32x4*)(rowp + bj * 128 + nn * 16) = acc[ai][bj][m][nn]; } }
    }
};
struct EpiY {
    static constexpr bool PERM = true, SEG = false;
    bf16_t* Gb;
    __device__ __forceinline__ void operator()(const Acc& acc, const Unit& u, int wr, int wc, int fr, int fq) const {
        const int g = u.pn, row0 = u.pm * 256 + wr * 64 + fr, col0 = wc * 32 + 8 * fq;
#pragma unroll
        for (int ai = 0; ai < 2; ++ai)
#pragma unroll
            for (int m = 0; m < 4; ++m) { const int n = row0 + ai * 128 + m * 16; if (n < NCHUNK) {
#pragma unroll
                for (int bj = 0; bj < 2; ++bj) { const int col = col0 + bj * 128, t = col >> 4, h0 = col & 15; float v[8];
#pragma unroll
                    for (int e = 0; e < 4; ++e) { v[e] = gelu_tanh(acc[ai][bj][m][0][e]); v[4 + e] = gelu_tanh(acc[ai][bj][m][1][e]); }
                    *(u32x4*)(Gb + (size_t)(n * 16 + t) * 512 + g * 16 + h0) = pack8(v); } } }
    }
};
struct EpiGlu {
    static constexpr bool PERM = true, SEG = false;
    const bf16_t* proj; bf16_t* U;
    __device__ __forceinline__ void operator()(const Acc& acc, const Unit& u, int wr, int wc, int fr, int fq) const {
        const int row0 = u.pm * 256 + wr * 64 + fr, col = u.pn * 128 + wc * 32 + 8 * fq;
#pragma unroll
        for (int ai = 0; ai < 2; ++ai)
#pragma unroll
            for (int m = 0; m < 4; ++m) { const int row = row0 + ai * 128 + m * 16;
                float z[8]; unpack8(*(const u32x4*)(proj + (size_t)row * NIN + 5632 + col), z);
                float v[8];
#pragma unroll
                for (int e = 0; e < 4; ++e) { v[e] = acc[ai][0][m][0][e] * sigmoidf_(acc[ai][1][m][0][e]) * z[e]; v[4 + e] = acc[ai][0][m][1][e] * sigmoidf_(acc[ai][1][m][1][e]) * z[4 + e]; }
                *(u32x4*)(U + (size_t)row * DM + 1536 + col) = pack8(v); }
    }
};
struct EpiBranch {
    static constexpr bool PERM = true, SEG = true;
    const bf16_t* R; bf16_t* mrg;
    __device__ __forceinline__ void segment(Acc& acc, const Unit& u, int seg, int wr, int wc, int fr, int fq) const {
        int loff = (((wr * 4 + wc) * 64) + fr + 16 * fq) * 8;
        asm volatile("" : "+v"(loff));
        const bf16_t* rbase = R + (size_t)(seg - 1) * T * DM + (size_t)(u.pm * 8 + u.pn) * 65536 + loff;
        u32x4 rr[2][4][2];
#pragma unroll
        for (int ai = 0; ai < 2; ++ai)
#pragma unroll
            for (int m = 0; m < 4; ++m)
#pragma unroll
                for (int bj = 0; bj < 2; ++bj) rr[ai][m][bj] = __builtin_nontemporal_load((const u32x4*)(rbase + ((ai * 4 + m) * 2 + bj) * 4096));
#pragma unroll
        for (int ai = 0; ai < 2; ++ai)
#pragma unroll
            for (int m = 0; m < 4; ++m)
#pragma unroll
                for (int bj = 0; bj < 2; ++bj) { float r[8]; unpack8(rr[ai][m][bj], r);
#pragma unroll
                    for (int e = 0; e < 4; ++e) { acc[ai][bj][m][0][e] *= r[e]; acc[ai][bj][m][1][e] *= r[4 + e]; } }
        __builtin_amdgcn_sched_barrier(0);
    }
    __device__ __forceinline__ void operator()(const Acc& acc, const Unit& u, int wr, int wc, int fr, int fq) const {
        const int row0 = u.pm * 256 + wr * 64 + fr, col0 = u.pn * 256 + wc * 32 + 8 * fq;
        const bf16_t* gbase = R + (size_t)3 * T * DM + (size_t)(u.pm * 8 + u.pn) * 65536 + (((wr * 4 + wc) * 64) + fr + 16 * fq) * 8;
#pragma unroll
        for (int ai = 0; ai < 2; ++ai)
#pragma unroll
            for (int m = 0; m < 4; ++m) { const int row = row0 + ai * 128 + m * 16;
#pragma unroll
                for (int bj = 0; bj < 2; ++bj) { float ga[8], v[8]; unpack8(*(const u32x4*)(gbase + ((ai * 4 + m) * 2 + bj) * 4096), ga);
#pragma unroll
                    for (int e = 0; e < 4; ++e) { v[e] = acc[ai][bj][m][0][e] * ga[e]; v[4 + e] = acc[ai][bj][m][1][e] * ga[4 + e]; }
                    *(u32x4*)(mrg + (size_t)row * DM + col0 + bj * 128) = pack8(v); } }
    }
};
struct EpiWo {
    static constexpr bool PERM = true, SEG = false;
    bf16_t* Y;
    __device__ __forceinline__ void operator()(const Acc& acc, const Unit& u, int wr, int wc, int fr, int fq) const {
        const int row0 = u.pm * 256 + wr * 64 + fr, col0 = u.pn * 256 + wc * 32 + 8 * fq;
#pragma unroll
        for (int ai = 0; ai < 2; ++ai)
#pragma unroll
            for (int m = 0; m < 4; ++m) { bf16_t* rowp = Y + (size_t)(row0 + ai * 128 + m * 16) * DM + col0;
#pragma unroll
                for (int bj = 0; bj < 2; ++bj) { const f32x4 v0 = acc[ai][bj][m][0], v1 = acc[ai][bj][m][1]; u32x4 w;
                    w.x = cvt_pk_bf16(v0[0], v0[1]); w.y = cvt_pk_bf16(v0[2], v0[3]); w.z = cvt_pk_bf16(v1[0], v1[1]); w.w = cvt_pk_bf16(v1[2], v1[3]);
                    *(u32x4*)(rowp + bj * 128) = w; } }
    }
};

__device__ void job_mod(PP p, unsigned char* smem, int job) {
    const int tid = opaque_tid(), layer = job / 48, col0 = (job % 48) * 128;
    float* cact = (float*)smem;
    float* red = cact + 5 * 2048;
    for (int i = tid; i < 5 * 2048; i += 512) { const int r = i >> 11, k = i & 2047; const float v = r < 4 ? p->c[r * 2048 + k] : p->c_ctx[k]; cact[i] = siluf_(v); }
    __syncthreads();
    const int cgp = tid & 31, ks = tid >> 5;
    float acc[5][4];
#pragma unroll
    for (int r = 0; r < 5; ++r)
#pragma unroll
        for (int j = 0; j < 4; ++j) acc[r][j] = 0.f;
    const float* wp = p->w_mod + (size_t)layer * 2048 * 6144 + col0 + cgp * 4;
#pragma unroll 4
    for (int k = ks; k < 2048; k += 16) { const f32x4 w = *(const f32x4*)(wp + (size_t)k * 6144);
#pragma unroll
        for (int r = 0; r < 5; ++r) { const float a = cact[r * 2048 + k];
#pragma unroll
            for (int j = 0; j < 4; ++j) acc[r][j] += a * w[j]; } }
#pragma unroll
    for (int r = 0; r < 5; ++r)
#pragma unroll
        for (int j = 0; j < 4; ++j) red[(ks * 5 + r) * 128 + cgp * 4 + j] = acc[r][j];
    __syncthreads();
    float* mod = (float*)(p->ws + WS_MOD);
    for (int o = tid; o < 640; o += 512) { const int r = o >> 7, cl = o & 127; float s = 0.f;
        for (int q = 0; q < 16; ++q) s += red[(q * 5 + r) * 128 + cl];
        mod[(size_t)(layer * 5 + r) * 6144 + col0 + cl] = s + p->b_mod[layer * 6144 + col0 + cl]; }
    __syncthreads();
}

__device__ void job_ssm(PP p, unsigned char* smem, int job) {
    const int tid = opaque_tid(), layer = job >> 5, g = job & 31;
    float* pw = (float*)smem;
    float* bb = pw + 2 * 17 * 64 * 2;
    float* cc = bb + 2 * 64 * 16 * 2;
    float* kk = cc + 2 * 16 * 64 * 2;
    float* dsk = kk + 2 * 16 * 16 * 16;
    if (tid < 128) {
        const int dir = tid >> 6, pp = tid & 63; const int idx = ((layer * 2 + dir) * 32 + g) * 64 + pp;
        const float are = p->a_re[idx], aim = p->a_im[idx], dt = expf(p->log_dt[(layer * 2 + dir) * 32 + g]);
        const float ex1 = are * dt, ang1 = aim * dt;
        for (int k = 0; k <= 16; ++k) { const float mag = expf(ex1 * (float)k), ang = ang1 * (float)k; const float kq = rintf(ang * 0.15915494309189535f);
            float rr = fmaf(-kq, 6.2831854820251465f, ang); rr = fmaf(-kq, -1.7484555e-7f, rr);
            pw[((dir * 17 + k) * 64 + pp) * 2 + 0] = mag * cosf(rr); pw[((dir * 17 + k) * 64 + pp) * 2 + 1] = mag * sinf(rr); }
        const float abr = pw[((dir * 17 + 1) * 64 + pp) * 2], abi = pw[((dir * 17 + 1) * 64 + pp) * 2 + 1];
        const float nr = abr - 1.0f, ni = abi, den = are * are + aim * aim;
        const float fre = (nr * are + ni * aim) / den, fim = (ni * are - nr * aim) / den;
        for (int h = 0; h < 16; ++h) { const float br = p->b_re[(size_t)idx * 16 + h], bi = p->b_im[(size_t)idx * 16 + h];
            bb[((dir * 64 + pp) * 16 + h) * 2 + 0] = fre * br - fim * bi; bb[((dir * 64 + pp) * 16 + h) * 2 + 1] = fre * bi + fim * br; }
        float* a16 = (float*)(p->ws + WS_A16);
        a16[(size_t)idx * 2 + 0] = pw[((dir * 17 + 16) * 64 + pp) * 2]; a16[(size_t)idx * 2 + 1] = pw[((dir * 17 + 16) * 64 + pp) * 2 + 1];
    }
    for (int i = tid; i < 2048; i += 512) { const int dir = i >> 10, h = (i >> 6) & 15, pp = i & 63; const size_t src = ((size_t)((layer * 2 + dir) * 32 + g) * 16 + h) * 64 + pp;
        cc[i * 2] = p->c_re[src]; cc[i * 2 + 1] = p->c_im[src]; }
    if (tid < 16) dsk[tid] = p->ssm_d[layer * 512 + g * 16 + tid];
    __syncthreads();
    {
        const int dir = tid >> 8, k = (tid >> 4) & 15, h = tid & 15;
        float acc[16];
#pragma unroll
        for (int e = 0; e < 16; ++e) acc[e] = 0.f;
        for (int pp = 0; pp < 64; ++pp) { const float cr = cc[((dir * 16 + h) * 64 + pp) * 2], ci = cc[((dir * 16 + h) * 64 + pp) * 2 + 1];
            const float ar = pw[((dir * 17 + k) * 64 + pp) * 2], ai = pw[((dir * 17 + k) * 64 + pp) * 2 + 1];
            const float car = cr * ar - ci * ai, cai = cr * ai + ci * ar;
#pragma unroll
            for (int e = 0; e < 16; ++e) acc[e] += car * bb[((dir * 64 + pp) * 16 + e) * 2] - cai * bb[((dir * 64 + pp) * 16 + e) * 2 + 1]; }
#pragma unroll
        for (int e = 0; e < 16; ++e) kk[((dir * 16 + k) * 16 + h) * 16 + e] = acc[e];
    }
    __syncthreads();
    bf16_t* Mg = (bf16_t*)(p->ws + WS_MG) + (size_t)(layer * 32 + g) * 256 * 512;
    for (int s = tid; s < 16384; s += 512) {
        const int row = s >> 6, col = (s & 63) * 8, t = row >> 4, h = row & 15; float v[8];
        if (col < 256) { const int j = col >> 4, h0 = col & 15;
#pragma unroll
            for (int e = 0; e < 8; ++e) { const int hp = h0 + e; float val = 0.f;
                if (j <= t) val += kk[((0 * 16 + (t - j)) * 16 + h) * 16 + hp];
                if (j >= t) val += kk[((1 * 16 + (j - t)) * 16 + h) * 16 + hp];
                if (j == t && hp == h) val += dsk[h];
                v[e] = val; } }
        else { const int dir = col >= 384 ? 1 : 0, pc = col - 256 - dir * 128, ri = pc >> 6, p0 = pc & 63, pwk = dir ? 16 - t : t + 1;
#pragma unroll
            for (int e = 0; e < 8; ++e) { const int pp = p0 + e; const float cr = cc[((dir * 16 + h) * 64 + pp) * 2], ci = cc[((dir * 16 + h) * 64 + pp) * 2 + 1];
                const float ar = pw[((dir * 17 + pwk) * 64 + pp) * 2], ai = pw[((dir * 17 + pwk) * 64 + pp) * 2 + 1];
                v[e] = ri ? -(cr * ai + ci * ar) : (cr * ar - ci * ai); } }
        *(u32x4*)(Mg + (size_t)row * 512 + col) = pack8(v);
    }
    bf16_t* Wg = (bf16_t*)(p->ws + WS_WG) + (size_t)(layer * 32 + g) * 256 * 256;
    for (int s = tid; s < 8192; s += 512) {
        const int row = s >> 5, col = (s & 31) * 8, dir = row >> 7, ri = (row >> 6) & 1, pp = row & 63, j = col >> 4, h0 = col & 15, ek = dir ? j : 15 - j;
        const float ar = pw[((dir * 17 + ek) * 64 + pp) * 2], ai = pw[((dir * 17 + ek) * 64 + pp) * 2 + 1]; float v[8];
#pragma unroll
        for (int e = 0; e < 8; ++e) { const float br = bb[((dir * 64 + pp) * 16 + h0 + e) * 2], bi = bb[((dir * 64 + pp) * 16 + h0 + e) * 2 + 1];
            v[e] = ri ? (ar * bi + ai * br) : (ar * br - ai * bi); }
        *(u32x4*)(Wg + (size_t)row * 256 + col) = pack8(v);
    }
    __syncthreads();
}

__device__ void job_fold(PP p, unsigned char* smem, int job) {
    const int tid = opaque_tid(), layer = job >> 7, gi = (job >> 5) & 3, k0 = (job & 31) * 64;
    float* wt = (float*)smem;
    float* pl = wt + 64 * 128;
    const float* src = p->w_in + (size_t)layer * DM * NIN + (size_t)k0 * NIN + 2048 + gi * 128;
#pragma unroll
    for (int i = 0; i < 4; ++i) { const int idx = tid + i * 512, k = idx >> 5, c4 = idx & 31; *(f32x4*)(wt + k * 128 + c4 * 4) = *(const f32x4*)(src + (size_t)k * NIN + c4 * 4); }
    const float* ps = p->pool_w + (size_t)(layer * 4 + gi) * 128 * 128;
#pragma unroll
    for (int i = 0; i < 8; ++i) { const int idx = tid + i * 512; *(f32x4*)(pl + idx * 4) = *(const f32x4*)(ps + idx * 4); }
    __syncthreads();
    const int d = tid & 127, kg = tid >> 7;
    float acc[16];
#pragma unroll
    for (int e = 0; e < 16; ++e) acc[e] = 0.f;
    for (int c = 0; c < 128; ++c) { const float w = pl[c * 128 + d];
#pragma unroll
        for (int e = 0; e < 16; ++e) acc[e] += wt[(kg * 16 + e) * 128 + c] * w; }
    const float sc = p->pool_scale[layer * 512 + gi * 128 + d];
    float v0[8], v1[8];
#pragma unroll
    for (int e = 0; e < 8; ++e) { v0[e] = acc[e] * sc; v1[e] = acc[8 + e] * sc; }
    bf16_t* dst = (bf16_t*)(p->ws + WS_WINT) + (size_t)layer * NIN * DM + (size_t)(2048 + gi * 128 + d) * DM + k0 + kg * 16;
    *(u32x4*)dst = pack8(v0); *(u32x4*)(dst + 8) = pack8(v1);
    __syncthreads();
}

__device__ void transpose_tile(const float* src, int srcld, int r0, int c0, bf16_t* dst, int dstld, int glu, unsigned char* smem) {
    const int tid = opaque_tid(); float* tile = (float*)smem;
    f32x4 v[8];
#pragma unroll
    for (int i = 0; i < 8; ++i) { const int idx = tid + i * 512, r = idx >> 6, c4 = idx & 63; v[i] = *(const f32x4*)(src + (size_t)(r0 + r) * srcld + c0 + c4 * 4); }
#pragma unroll
    for (int i = 0; i < 8; ++i) { const int idx = tid + i * 512, r = idx >> 6, c4 = idx & 63; float* q = tile + r * 257 + c4 * 4; q[0] = v[i][0]; q[1] = v[i][1]; q[2] = v[i][2]; q[3] = v[i][3]; }
    __syncthreads();
#pragma unroll
    for (int i = 0; i < 4; ++i) { const int id = tid + i * 512, r8 = id & 7, c = id >> 3; float f[8];
#pragma unroll
        for (int e = 0; e < 8; ++e) f[e] = tile[(r8 * 8 + e) * 257 + c];
        int drow = c0 + c;
        if (glu == 1) { drow = (drow < 512) ? ((drow >> 7) * 256 + (drow & 127)) : ((((drow - 512) >> 7) * 256) + 128 + ((drow - 512) & 127)); }
        else if (glu == 2 && drow >= 6144) {
            const int cc = drow - 6144, br = cc >> 11, ch = cc & 2047, pnl = ch >> 6, chl = ch & 63;
            drow = 6144 + 256 * pnl + 128 * (br >> 1) + 32 * (chl >> 4) + 8 * ((chl >> 2) & 3) + 4 * (br & 1) + (chl & 3); }
        *(u32x4*)(dst + (size_t)drow * dstld + r0 + r8 * 8) = pack8(f); }
    __syncthreads();
}

__device__ __forceinline__ void prep_layer_jobs(PP p, unsigned char* smem, int layer, int start, int stride, int jlo, int jhi) {
    for (int j = jlo + start; j < jhi; j += stride) {
        if (j < 48) job_mod(p, smem, layer * 48 + j);
        else if (j < 80) job_ssm(p, smem, layer * 32 + (j - 48));
        else if (j < 208) job_fold(p, smem, layer * 128 + (j - 80));
        else if (j < 2000) { const int rem = j - 208, rt = rem / 56, ct = rem % 56; if (ct == 8 || ct == 9) continue;
            transpose_tile(p->w_in + (size_t)layer * DM * NIN, NIN, rt * 64, ct * 256, (bf16_t*)(p->ws + WS_WINT) + (size_t)layer * NIN * DM, DM, 2, smem); }
        else if (j < 2256) { const int rem = j - 2000, rt = rem >> 3, ct = rem & 7;
            transpose_tile(p->w_br + (size_t)layer * DM * DM, DM, rt * 64, ct * 256, (bf16_t*)(p->ws + WS_WBRT) + (size_t)layer * DM * DM, DM, 0, smem); }
        else if (j < 2512) { const int rem = j - 2256, rt = rem >> 3, ct = rem & 7;
            transpose_tile(p->w_o + (size_t)layer * DM * DM, DM, rt * 64, ct * 256, (bf16_t*)(p->ws + WS_WOT) + (size_t)layer * DM * DM, DM, 0, smem); }
        else { const int rem = j - 2512, rt = rem >> 2, ct = rem & 3;
            transpose_tile(p->glu_w + (size_t)layer * 512 * 1024, 1024, rt * 64, ct * 256, (bf16_t*)(p->ws + WS_GLUT) + (size_t)layer * 1024 * 512, 512, 1, smem); }
    }
}

__device__ __forceinline__ float wave_sum(float v) {
#pragma unroll
    for (int o = 32; o >= 1; o >>= 1) v += __shfl_xor(v, o);
    return v;
}
__device__ __forceinline__ void norm_row(int layer, const float* xin, float* xst, const bf16_t* yrow, bf16_t* hrow, const float* sm, const float* smb, int lane) {
    f32x4 xv[8];
#pragma unroll
    for (int q = 0; q < 8; ++q) xv[q] = *(const f32x4*)(xin + (q * 64 + lane) * 4);
    if (layer >= 1) {
        f32x4 yv[8]; float ss = 0.f;
#pragma unroll
        for (int q = 0; q < 8; ++q) { const uint2 yw = *(const uint2*)(yrow + (q * 64 + lane) * 4); yv[q] = (f32x4){bflo(yw.x), bfhi(yw.x), bflo(yw.y), bfhi(yw.y)}; ss += yv[q][0] * yv[q][0] + yv[q][1] * yv[q][1] + yv[q][2] * yv[q][2] + yv[q][3] * yv[q][3]; }
        ss = wave_sum(ss); const float rs = rsqrtf(ss * (1.0f / DM) + 1e-6f);
#pragma unroll
        for (int q = 0; q < 8; ++q) { const int col = (q * 64 + lane) * 4; const f32x4 gt = *(const f32x4*)(smb + 2 * DM + col), gg = *(const f32x4*)(sm + DM + col);
#pragma unroll
            for (int e = 0; e < 4; ++e) xv[q][e] += gt[e] * (yv[q][e] * rs * gg[e]);
            *(f32x4*)(xst + col) = xv[q]; }
    }
    if (layer < 4) {
        float ss = 0.f;
#pragma unroll
        for (int q = 0; q < 8; ++q) ss += xv[q][0] * xv[q][0] + xv[q][1] * xv[q][1] + xv[q][2] * xv[q][2] + xv[q][3] * xv[q][3];
        ss = wave_sum(ss); const float rs = rsqrtf(ss * (1.0f / DM) + 1e-6f);
#pragma unroll
        for (int q = 0; q < 8; ++q) { const int col = (q * 64 + lane) * 4; const f32x4 sh = *(const f32x4*)(smb + col), sc = *(const f32x4*)(smb + DM + col), gg = *(const f32x4*)(sm + col);
            float h[4];
#pragma unroll
            for (int e = 0; e < 4; ++e) h[e] = (xv[q][e] * rs * gg[e]) * (1.0f + sc[e]) + sh[e];
            uint2 w; w.x = cvt_pk_bf16(h[0], h[1]); w.y = cvt_pk_bf16(h[2], h[3]);
            *(uint2*)(hrow + col) = w; }
    }
}
__device__ void norm_phase(PP p, int layer, unsigned char* smem) {
    const int tid = opaque_tid(), wid = tid >> 6, lane = tid & 63, blk = blockIdx.x;
    const float* mod = (const float*)(p->ws + WS_MOD);
    const bf16_t* Y = (const bf16_t*)(p->ws + WS_Y);
    bf16_t* H = (bf16_t*)(p->ws + WS_H);
    float* XC = (float*)(p->ws + WS_XC);
    float* sm = (float*)smem;
    const int b = (blk * 64) >> 12;
    for (int i = tid; i < DM / 4; i += 512) { const int c4 = i * 4;
        if (layer < 4) { *(f32x4*)(sm + c4) = *(const f32x4*)(p->g_pre + layer * DM + c4);
            *(f32x4*)(sm + 2 * DM + c4) = *(const f32x4*)(mod + (size_t)(layer * 5 + b) * 6144 + c4); *(f32x4*)(sm + 3 * DM + c4) = *(const f32x4*)(mod + (size_t)(layer * 5 + b) * 6144 + DM + c4);
            *(f32x4*)(sm + 5 * DM + c4) = *(const f32x4*)(mod + (size_t)(layer * 5 + 4) * 6144 + c4); *(f32x4*)(sm + 6 * DM + c4) = *(const f32x4*)(mod + (size_t)(layer * 5 + 4) * 6144 + DM + c4); }
        if (layer >= 1) { *(f32x4*)(sm + DM + c4) = *(const f32x4*)(p->g_post + (layer - 1) * DM + c4);
            *(f32x4*)(sm + 4 * DM + c4) = *(const f32x4*)(mod + (size_t)((layer - 1) * 5 + b) * 6144 + 2 * DM + c4); *(f32x4*)(sm + 7 * DM + c4) = *(const f32x4*)(mod + (size_t)((layer - 1) * 5 + 4) * 6144 + 2 * DM + c4); } }
    __syncthreads();
    for (int i = 0; i < 8; ++i) { const int row = blk * 64 + wid * 8 + i;
        float* xst = p->out + (size_t)row * DM; const float* xin = (layer <= 1) ? p->x + (size_t)row * DM : xst;
        norm_row(layer, xin, xst, Y + (size_t)row * DM, H + (size_t)row * DM, sm, sm + 2 * DM, lane); }
    if (layer < 4 && (wid & 1) == 0) { const int cr = blk * 4 + (wid >> 1), row = TLAT + cr;
        float* xst = XC + (size_t)cr * DM; const float* xin = (layer <= 1) ? p->ctx + (size_t)cr * DM : xst;
        norm_row(layer, xin, xst, Y + (size_t)row * DM, H + (size_t)row * DM, sm, sm + 5 * DM, lane); }
    __syncthreads();
}

__device__ void attn_phase(PP p, int layer) {
    const int tid = opaque_tid(), wid = tid >> 6, lane = tid & 63, qi = lane & 15, quad = lane >> 4;
    const bf16_t* PROJ = (const bf16_t*)(p->ws + WS_PROJ); const bf16_t* VT = (const bf16_t*)(p->ws + WS_VT); bf16_t* U = (bf16_t*)(p->ws + WS_U);
    const int ntask = 8192 + (layer < 3 ? 512 : 0);
    for (int task = blockIdx.x * 8 + wid; task < ntask; task += gridDim.x * 8) {
        int b, head, tq0, nband, r = 0, ct = 0, rs = 0, cs = 0;
        if (task < 8192) { ct = task & 3; r = (task >> 2) & 63; head = (task >> 8) & 7; b = task >> 11; tq0 = b * SEQ + r * 64 + ct * 16;
            rs = min(max(r - 4, 0), 56); cs = min(max(ct * 16 - 8, 0), 32); nband = 8; }
        else { const int t2 = task - 8192; head = (t2 >> 4) & 7; b = t2 >> 7; tq0 = TLAT + b * NCTX + (t2 & 15) * 16; nband = 0; }
        const bf16_t* qp = PROJ + (size_t)(tq0 + qi) * NIN + head * 64 + quad * 8;
        const bf16x8 qf0 = *(const bf16x8*)qp, qf1 = *(const bf16x8*)(qp + 32);
        f32x4 O[4];
#pragma unroll
        for (int dt = 0; dt < 4; ++dt) O[dt] = (f32x4){0.f, 0.f, 0.f, 0.f};
        float mrun = -1e30f, lrun = 0.f;
        const int qcol = ct * 16 + qi, start = min(max(qcol - 8, 0), 48);
        const float* rpbh = p->na_rpb + (size_t)(layer * 8 + head) * 15 * 31;
        const int kidx0 = (qi >> 2) * 8 + (qi & 3);
        const int nblk = nband + 8;
        for (int blk = 0; blk < nblk; blk += 2) {
            const bool band = blk < nband;
            bf16x8 kf[2][4], vf[2][4]; float sc[16];
#pragma unroll
            for (int h = 0; h < 2; ++h) {
                const int bb = blk + h;
                const int kb = band ? b * SEQ + (rs + bb) * 64 + cs : TLAT + b * NCTX + (bb - nband) * 32;
                const bf16_t* kp = PROJ + (size_t)(kb + kidx0) * NIN + 512 + head * 64 + quad * 8;
                kf[h][0] = *(const bf16x8*)kp; kf[h][1] = *(const bf16x8*)(kp + 32); kf[h][2] = *(const bf16x8*)(kp + 4 * NIN); kf[h][3] = *(const bf16x8*)(kp + 4 * NIN + 32);
                const bf16_t* vp = VT + (size_t)(head * 64 + qi) * T + kb + quad * 8;
#pragma unroll
                for (int dt = 0; dt < 4; ++dt) vf[h][dt] = *(const bf16x8*)(vp + (size_t)dt * 16 * T);
#pragma unroll
                for (int e = 0; e < 8; ++e) { float bias = 0.f;
                    if (band) { const int dcol = min(max(cs + quad * 8 + e - qcol + 15, 0), 30); bias = rpbh[(rs + bb - r + 7) * 31 + dcol]; }
                    sc[h * 8 + e] = bias; }
            }
#pragma unroll
            for (int h = 0; h < 2; ++h) {
                f32x4 s0 = (f32x4){0.f, 0.f, 0.f, 0.f}, s1 = (f32x4){0.f, 0.f, 0.f, 0.f};
                s0 = __builtin_amdgcn_mfma_f32_16x16x32_bf16(kf[h][0], qf0, s0, 0, 0, 0); s0 = __builtin_amdgcn_mfma_f32_16x16x32_bf16(kf[h][1], qf1, s0, 0, 0, 0);
                s1 = __builtin_amdgcn_mfma_f32_16x16x32_bf16(kf[h][2], qf0, s1, 0, 0, 0); s1 = __builtin_amdgcn_mfma_f32_16x16x32_bf16(kf[h][3], qf1, s1, 0, 0, 0);
#pragma unroll
                for (int e = 0; e < 8; ++e) { float sv = ((e < 4) ? s0[e & 3] : s1[e & 3]) + sc[h * 8 + e];
                    if (band) { const int kcol = cs + quad * 8 + e; const bool ok = (kcol >= start) && (kcol < start + 16); sv = ok ? sv : -1e30f; }
                    sc[h * 8 + e] = sv; }
            }
            float mx = sc[0];
#pragma unroll
            for (int e = 1; e < 16; ++e) mx = fmaxf(mx, sc[e]);
            mx = fmaxf(mx, __shfl_xor(mx, 16)); mx = fmaxf(mx, __shfl_xor(mx, 32));
            const float mnew = fmaxf(mrun, mx), alpha = __expf(mrun - mnew);
            float ps = 0.f, pv[16];
#pragma unroll
            for (int e = 0; e < 16; ++e) { pv[e] = __expf(sc[e] - mnew); ps += pv[e]; }
            lrun = lrun * alpha + ps; mrun = mnew;
#pragma unroll
            for (int jj = 0; jj < 4; ++jj) { const float aj = __shfl(alpha, quad * 4 + jj);
#pragma unroll
                for (int dt = 0; dt < 4; ++dt) O[dt][jj] *= aj; }
#pragma unroll
            for (int h = 0; h < 2; ++h) { float ph[8];
#pragma unroll
                for (int e = 0; e < 8; ++e) ph[e] = pv[h * 8 + e];
                const u32x4 pw4 = pack8(ph); bf16x8 pf; __builtin_memcpy(&pf, &pw4, 16);
#pragma unroll
                for (int dt = 0; dt < 4; ++dt) O[dt] = __builtin_amdgcn_mfma_f32_16x16x32_bf16(pf, vf[h][dt], O[dt], 0, 0, 0); }
        }
        float ltot = lrun + __shfl_xor(lrun, 16); ltot += __shfl_xor(ltot, 32);
        const float inv = 1.0f / ltot;
#pragma unroll
        for (int jj = 0; jj < 4; ++jj) { const float ij = __shfl(inv, quad * 4 + jj); const int tok = tq0 + quad * 4 + jj;
#pragma unroll
            for (int dt = 0; dt < 4; ++dt) { const int d = dt * 16 + qi; const float z = bf2f(PROJ[(size_t)tok * NIN + 1536 + head * 64 + d]);
                U[(size_t)tok * DM + head * 64 + d] = f2bf(O[dt][jj] * ij * z); } }
    }
}

__device__ void elem_phase(PP p, int layer) {
    const bf16_t* __restrict__ PROJ = (const bf16_t*)(p->ws + WS_PROJ); bf16_t* __restrict__ U = (bf16_t*)(p->ws + WS_U);
    const int nitems = (TLAT / 16) * 128;
    for (int it = blockIdx.x * 512 + opaque_tid(); it < nitems; it += gridDim.x * 512) {
        const int chunk = it >> 7, cgp = it & 127, tok0 = chunk * 16;
        int l0, L; if (tok0 < TLAT) { l0 = tok0 & (SEQ - 1); L = SEQ; } else { l0 = (tok0 - TLAT) & (NCTX - 1); L = NCTX; }
        const int seq0 = tok0 - l0;
        if (cgp < 64) {
            const int c0 = cgp * 8, gi = c0 >> 7, w = 2 << gi, hw = w >> 1;
            const bf16_t* ub = PROJ + (size_t)seq0 * NIN + 2048 + c0;
            int lo = max(l0 - hw, 0), hi = min(l0 + w - hw, L);
            float s[8];
#pragma unroll
            for (int e = 0; e < 8; ++e) s[e] = 0.f;
            for (int tt = lo; tt < hi; ++tt) { float f[8]; unpack8(*(const u32x4*)(ub + (size_t)tt * NIN), f);
#pragma unroll
                for (int e = 0; e < 8; ++e) s[e] += f[e]; }
#pragma unroll 4
            for (int i = 0; i < 16; ++i) { const int l = l0 + i;
                float self[8], z[8]; unpack8(*(const u32x4*)(ub + (size_t)l * NIN), self); unpack8(*(const u32x4*)(ub + (size_t)l * NIN + 512), z);
                const float ic = 1.0f / (float)(hi - lo); float o[8];
#pragma unroll
                for (int e = 0; e < 8; ++e) o[e] = (s[e] * ic - self[e]) * z[e];
                *(u32x4*)(U + (size_t)(seq0 + l) * DM + 512 + c0) = pack8(o);
                const int nhi = min(l + 1 + w - hw, L), nlo = max(l + 1 - hw, 0);
                if (nhi > hi) { float f[8]; unpack8(*(const u32x4*)(ub + (size_t)hi * NIN), f);
#pragma unroll
                    for (int e = 0; e < 8; ++e) s[e] += f[e];
                    hi = nhi; }
                if (nlo > lo) { float f[8]; unpack8(*(const u32x4*)(ub + (size_t)lo * NIN), f);
#pragma unroll
                    for (int e = 0; e < 8; ++e) s[e] -= f[e];
                    lo = nlo; } }
        } else {
            const int c0 = (cgp - 64) * 8; const bf16_t* base = PROJ + (size_t)seq0 * NIN + c0;
            const float* cw = p->conv_w + (size_t)layer * 3 * 512 + c0;
            float w0[8], w1[8], w2[8];
#pragma unroll
            for (int e = 0; e < 8; ++e) { w0[e] = cw[e]; w1[e] = cw[512 + e]; w2[e] = cw[1024 + e]; }
            float xm[8], x0[8], xp[8];
            if (l0 > 0) { float a[8], c[8]; unpack8(*(const u32x4*)(base + (size_t)(l0 - 1) * NIN + 3072), a); unpack8(*(const u32x4*)(base + (size_t)(l0 - 1) * NIN + 4096), c);
#pragma unroll
                for (int e = 0; e < 8; ++e) xm[e] = a[e] * c[e]; }
            else {
#pragma unroll
                for (int e = 0; e < 8; ++e) xm[e] = 0.f; }
            { float a[8], c[8]; unpack8(*(const u32x4*)(base + (size_t)l0 * NIN + 3072), a); unpack8(*(const u32x4*)(base + (size_t)l0 * NIN + 4096), c);
#pragma unroll
                for (int e = 0; e < 8; ++e) x0[e] = a[e] * c[e]; }
#pragma unroll 4
            for (int i = 0; i < 16; ++i) { const int l = l0 + i;
                if (l < L - 1) { float a[8], c[8]; unpack8(*(const u32x4*)(base + (size_t)(l + 1) * NIN + 3072), a); unpack8(*(const u32x4*)(base + (size_t)(l + 1) * NIN + 4096), c);
#pragma unroll
                    for (int e = 0; e < 8; ++e) xp[e] = a[e] * c[e]; }
                else {
#pragma unroll
                    for (int e = 0; e < 8; ++e) xp[e] = 0.f; }
                float gb[8], z[8]; unpack8(*(const u32x4*)(base + (size_t)l * NIN + 3584), gb); unpack8(*(const u32x4*)(base + (size_t)l * NIN + 4608), z);
                float o[8];
#pragma unroll
                for (int e = 0; e < 8; ++e) o[e] = gb[e] * (w0[e] * xm[e] + w1[e] * x0[e] + w2[e] * xp[e]) * z[e];
                *(u32x4*)(U + (size_t)(seq0 + l) * DM + 1024 + c0) = pack8(o);
#pragma unroll
                for (int e = 0; e < 8; ++e) { xm[e] = x0[e]; x0[e] = xp[e]; } }
        }
    }
}

__device__ void elem_ctx_tokens(PP p, int layer) {
    const bf16_t* __restrict__ PROJ = (const bf16_t*)(p->ws + WS_PROJ); bf16_t* __restrict__ U = (bf16_t*)(p->ws + WS_U);
    const int nitems = TCTX * 128;
#pragma unroll 2
    for (int it = blockIdx.x * 512 + opaque_tid(); it < nitems; it += gridDim.x * 512) {
        const int tok = TLAT + (it >> 7), cgp = it & 127;
        int l, L; if (tok < TLAT) { l = tok & (SEQ - 1); L = SEQ; } else { l = (tok - TLAT) & (NCTX - 1); L = NCTX; }
        const int seq0 = tok - l;
        if (cgp < 64) {
            const int c0 = cgp * 8, gi = c0 >> 7, w = 2 << gi, lo = max(l - (w >> 1), 0), hi = min(l + w - (w >> 1), L);
            float s[8];
#pragma unroll
            for (int e = 0; e < 8; ++e) s[e] = 0.f;
            for (int tt = lo; tt < hi; ++tt) { float f[8]; unpack8(*(const u32x4*)(PROJ + (size_t)(seq0 + tt) * NIN + 2048 + c0), f);
#pragma unroll
                for (int e = 0; e < 8; ++e) s[e] += f[e]; }
            float self[8], z[8]; unpack8(*(const u32x4*)(PROJ + (size_t)tok * NIN + 2048 + c0), self); unpack8(*(const u32x4*)(PROJ + (size_t)tok * NIN + 2560 + c0), z);
            const float ic = 1.0f / (float)(hi - lo); float o[8];
#pragma unroll
            for (int e = 0; e < 8; ++e) o[e] = (s[e] * ic - self[e]) * z[e];
            *(u32x4*)(U + (size_t)tok * DM + 512 + c0) = pack8(o);
        } else {
            const int c0 = (cgp - 64) * 8; const bf16_t* base = PROJ + (size_t)tok * NIN + c0;
            float xm[8], x0[8], xp[8], cm[8], c0v[8], cp[8], gb[8], z[8];
            unpack8(*(const u32x4*)(base + 3072), x0); unpack8(*(const u32x4*)(base + 4096), c0v); unpack8(*(const u32x4*)(base + 3584), gb); unpack8(*(const u32x4*)(base + 4608), z);
            if (l > 0) { unpack8(*(const u32x4*)(base - NIN + 3072), xm); unpack8(*(const u32x4*)(base - NIN + 4096), cm); }
            else {
#pragma unroll
                for (int e = 0; e < 8; ++e) { xm[e] = 0.f; cm[e] = 0.f; } }
            if (l < L - 1) { unpack8(*(const u32x4*)(base + NIN + 3072), xp); unpack8(*(const u32x4*)(base + NIN + 4096), cp); }
            else {
#pragma unroll
                for (int e = 0; e < 8; ++e) { xp[e] = 0.f; cp[e] = 0.f; } }
            const float* cw = p->conv_w + (size_t)layer * 3 * 512 + c0; float o[8];
#pragma unroll
            for (int e = 0; e < 8; ++e) o[e] = gb[e] * (cw[e] * (xm[e] * cm[e]) + cw[512 + e] * (x0[e] * c0v[e]) + cw[1024 + e] * (xp[e] * cp[e])) * z[e];
            *(u32x4*)(U + (size_t)tok * DM + 1024 + c0) = pack8(o);
        }
    }
}

__device__ void carry_phase(PP p, int layer) {
    const int id = (gridDim.x - 1 - blockIdx.x) * 512 + opaque_tid(); if (id >= 16384) return;
    const int pp = id & 63, g = (id >> 6) & 31, dir = (id >> 11) & 1, b = id >> 12;
    const float* a16 = (const float*)(p->ws + WS_A16) + (size_t)(((layer * 2 + dir) * 32 + g) * 64 + pp) * 2;
    const float ar = a16[0], ai = a16[1];
    const float* E = (const float*)(p->ws + WS_E) + (size_t)g * XROWS * 256 + dir * 128 + pp;
    bf16_t* X = (bf16_t*)(p->ws + WS_X) + (size_t)g * XROWS * 512 + 256 + dir * 128 + pp;
    float sr = 0.f, si = 0.f;
    for (int s0 = 0; s0 < 272; s0 += 8) {
        float er[8], ei[8]; int nn[8];
#pragma unroll
        for (int q = 0; q < 8; ++q) { const int s = s0 + q; int n;
            if (s < 16) n = 1024 + b * 16 + (dir ? 15 - s : s); else n = b * 256 + (dir ? 255 - (s - 16) : (s - 16));
            nn[q] = n; er[q] = E[(size_t)n * 256]; ei[q] = E[(size_t)n * 256 + 64]; }
#pragma unroll
        for (int q = 0; q < 8; ++q) { X[(size_t)nn[q] * 512] = f2bf(sr); X[(size_t)nn[q] * 512 + 64] = f2bf(si);
            const float nr = ar * sr - ai * si + er[q], ni = ar * si + ai * sr + ei[q]; sr = nr; si = ni; }
    }
}

#define XB_TMO      128
#define XB_XCNT(j)  (256  + 64 * (j))
#define XB_XSUB(j)  (1280 + 64 * (j))
#define XB_XGEN(j)  (2304 + 64 * (j))
#define XB_TOP      3328
#define XB_TOPGEN   3392
#define XCD_BAR_WORDS 3456
#define XB_SPIN_CAP (1u << 18)
__device__ __forceinline__ unsigned xb_ld(unsigned* p)              { return __hip_atomic_load(p, __ATOMIC_RELAXED, __HIP_MEMORY_SCOPE_AGENT); }
__device__ __forceinline__ unsigned xb_add(unsigned* p, unsigned v) { return __hip_atomic_fetch_add(p, v, __ATOMIC_RELAXED, __HIP_MEMORY_SCOPE_AGENT); }
__device__ __forceinline__ unsigned xb_xcc_id() { return (unsigned)__builtin_amdgcn_s_getreg((3 << 11) | 20) & 0xFu; }
#define XB_SPIN(cond, bar) do { unsigned _sp = 0; while (cond) { __builtin_amdgcn_s_sleep(1); \
    if ((++_sp & 255u) == 0u) { if (xb_ld(&(bar)[XB_TMO])) break; if (_sp > XB_SPIN_CAP) { atomicAdd(&(bar)[XB_TMO], 1u); break; } } } } while (0)
__device__ __forceinline__ void xcd_barrier_complete(unsigned* bar, unsigned x, unsigned& nloc, unsigned& nx) {
    const unsigned G = gridDim.x;
    unsigned sum, cnt, mine, sp = 0u;
    for (;;) {
        sum = 0u; cnt = 0u; mine = 0u;
#pragma unroll
        for (unsigned j = 0; j < 16; ++j) { const unsigned c = xb_ld(&bar[XB_XCNT(j)]); sum += c; cnt += (c > 0u) ? 1u : 0u; mine = (j == x) ? c : mine; }
        if (sum == G) break;
        __builtin_amdgcn_s_sleep(1);
        if ((++sp & 255u) == 0u) { if (xb_ld(&bar[XB_TMO])) break; if (sp > XB_SPIN_CAP) { atomicAdd(&bar[XB_TMO], 1u); break; } }
    }
    nloc = mine > 0u ? mine : 1u; nx = cnt > 0u ? cnt : 1u;
}
__device__ __forceinline__ void xcd_barrier(unsigned* bar, volatile LAS unsigned* st) {
    asm volatile("s_waitcnt vmcnt(0)" ::: "memory");
    __syncthreads();
    if (threadIdx.x == 0) {
        __builtin_amdgcn_s_waitcnt(0);
        const unsigned x = xb_xcc_id();
        unsigned nloc = st[0], nx = st[1];
        if (nloc == 0u) { xcd_barrier_complete(bar, x, nloc, nx); st[0] = nloc; st[1] = nx; }
        const unsigned old = xb_add(&bar[XB_XSUB(x)], 1u);
        const unsigned gen = old / nloc;
        if (old + 1u == (gen + 1u) * nloc) {
            __builtin_amdgcn_fence(__ATOMIC_RELEASE, "agent");
            asm volatile("s_waitcnt vmcnt(0)" ::: "memory");
            const unsigned og = xb_add(&bar[XB_TOP], 1u);
            const unsigned tg = og / nx;
            if (og + 1u == (tg + 1u) * nx) xb_add(&bar[XB_TOPGEN], 1u);
            else XB_SPIN(xb_ld(&bar[XB_TOPGEN]) == tg, bar);
            __builtin_amdgcn_fence(__ATOMIC_ACQUIRE, "agent");
            xb_add(&bar[XB_XGEN(x)], 1u);
            asm volatile("s_waitcnt vmcnt(0)" ::: "memory");
        } else {
            XB_SPIN(xb_ld(&bar[XB_XGEN(x)]) == gen, bar);
            __builtin_amdgcn_fence(__ATOMIC_ACQUIRE, "agent");
            asm volatile("s_waitcnt vmcnt(0)" ::: "memory");
        }
    }
    __syncthreads();
}

template <int PMASK> __device__ __forceinline__ void run_phase(PP p, int ph, unsigned char* smem) {
    LAS unsigned char* lds = (LAS unsigned char*)smem;
    const int G = gridDim.x, c = blockIdx.x;
    if (ph == 0) { if constexpr ((PMASK >> 8) & 1) prep_layer_jobs(p, smem, 0, blockIdx.x, gridDim.x, 0, 2544); return; }
    if (ph == 33) { if constexpr ((PMASK >> 0) & 1) norm_phase(p, 4, smem); return; }
    const int layer = (ph - 1) >> 3, sub = (ph - 1) & 7;
    const char* ws = (const char*)p->ws;
    switch (sub) {
    case 0: if constexpr ((PMASK >> 0) & 1) norm_phase(p, layer, smem); break;
    case 1: if constexpr ((PMASK >> 1) & 1) { OrderInproj S{ws + WS_WINT + (size_t)layer * NIN * DM * 2, ws + WS_H, G, c};
        EpiInproj Ep{(bf16_t*)(p->ws + WS_PROJ), (bf16_t*)(p->ws + WS_VT), (bf16_t*)(p->ws + WS_X), p->b_gate + layer * 8192, (bf16_t*)(p->ws + WS_R)};
        pg8::gemm_phase(lds, pg8::Gemm{DM, DM, DM}, S, Ep); } break;
    case 2: if constexpr ((PMASK >> 2) & 1) { OrderGroup S{ws + WS_X, ws + WS_WG + (size_t)layer * 32 * 256 * 256 * 2, 256, G, c};
        EpiE Ep{(float*)(p->ws + WS_E)};
        pg8::gemm_phase(lds, pg8::Gemm{512, 256, 256}, S, Ep); } break;
    case 3: if constexpr ((PMASK >> 3) & 1) { carry_phase(p, layer); attn_phase(p, layer); elem_phase(p, layer); if (layer < 3) elem_ctx_tokens(p, layer);
#ifdef DUP3
        if (DUP3 & 1) carry_phase(p, layer);
        if (DUP3 & 2) attn_phase(p, layer);
        if (DUP3 & 4) elem_phase(p, layer);
#endif
        } break;
    case 4: if constexpr ((PMASK >> 4) & 1) { OrderGroup S{ws + WS_X, ws + WS_MG + (size_t)layer * 32 * 256 * 512 * 2, 512, G, c};
        EpiY Ep{(bf16_t*)(p->ws + WS_G)};
        pg8::gemm_phase(lds, pg8::Gemm{512, 512, 512}, S, Ep); } break;
    case 5: if constexpr ((PMASK >> 5) & 1) { OrderSimple S{ws + WS_G, ws + WS_GLUT + (size_t)layer * 1024 * 512 * 2, layer == 3 ? 64 : 68, 4, 512, 512, G, c};
        EpiGlu Ep{(const bf16_t*)(p->ws + WS_PROJ), (bf16_t*)(p->ws + WS_U)};
        pg8::gemm_phase(lds, pg8::Gemm{512, 512, 512}, S, Ep); } break;
    case 6: if constexpr ((PMASK >> 6) & 1) { OrderSimple S{ws + WS_U, ws + WS_WBRT + (size_t)layer * DM * DM * 2, layer == 3 ? 64 : 68, 8, DM, DM, G, c};
        EpiBranch Ep{(const bf16_t*)(p->ws + WS_R), (bf16_t*)(p->ws + WS_MRG)};
        pg8::gemm_phase(lds, pg8::Gemm{DM, DM, DM}, S, Ep);
        if (layer < 3 && c >= 32) { __syncthreads(); prep_layer_jobs(p, smem, layer + 1, c - 32, G - 32, 0, 2544); } } break;
    case 7: if constexpr ((PMASK >> 7) & 1) { OrderSimple S{ws + WS_MRG, ws + WS_WOT + (size_t)layer * DM * DM * 2, layer == 3 ? 64 : 68, 8, DM, DM, G, c};
        EpiWo Ep{(bf16_t*)(p->ws + WS_Y)};
        pg8::gemm_phase(lds, pg8::Gemm{DM, DM, DM}, S, Ep);
        if (layer < 3 && c >= 32) { __syncthreads(); prep_layer_jobs(p, smem, layer + 1, c - 32, G - 32, 2544, 2544); } } break;
    }
}

template <int PMASK> __global__ void __launch_bounds__(512, 2) hybrid_mega(Params p_byval) {
    extern __shared__ __attribute__((aligned(16))) unsigned char smem[];
    cg::grid_group grid = cg::this_grid();
    PP p0 = (PP)__builtin_amdgcn_kernarg_segment_ptr();
    const int lo = p0->ph_lo, hi = p0->ph_hi;
    {
        volatile LAS unsigned* st = (volatile LAS unsigned*)((LAS unsigned char*)smem + 131072);
        if (threadIdx.x == 0) { st[0] = 0u; st[1] = 0u; (void)xb_add(&((unsigned*)(p0->ws + WS_BAR))[XB_XCNT(xb_xcc_id())], 1u); }
        __syncthreads();
    }
    for (int ph = lo; ph < hi; ++ph) {
        if (ph == lo + 1) grid.sync();
        else if (ph > lo) { PP pb = p0; asm volatile("" : "+s"(pb)); xcd_barrier((unsigned*)(pb->ws + WS_BAR), (volatile LAS unsigned*)((LAS unsigned char*)smem + 131072)); }
        PP p = p0; asm volatile("" : "+s"(p));
        run_phase<PMASK>(p, ph, smem);
#ifdef DUP_SUB
        if (ph >= 1 && ph <= 32 && ((ph - 1) & 7) == DUP_SUB) { grid.sync(); PP p2 = p0; asm volatile("" : "+s"(p2)); run_phase<PMASK>(p2, ph, smem); }
#endif
#ifdef DUP_NORM0
        if (ph == 1) { grid.sync(); PP p2 = p0; asm volatile("" : "+s"(p2)); run_phase<PMASK>(p2, ph, smem); }
#endif
#ifdef DUP_PREP
        if (ph == 0) { grid.sync(); PP p2 = p0; asm volatile("" : "+s"(p2)); run_phase<PMASK>(p2, ph, smem); }
#endif
    }
}

extern "C" void kernel_launch(void* const* d_in, const int* in_sizes, int n_in, void* d_out, int out_size, void* d_ws, size_t ws_size, hipStream_t stream) {
    static int grid = 0;
    if (grid == 0) {
        if (n_in != 25 || ws_size < WS_END) { fprintf(stderr, "kernel_launch: unexpected n_in %d or ws_size %zu (< %zu)\n", n_in, ws_size, (size_t)WS_END); grid = -1; return; }
        bool okattr = true;
#if MULTI_LAUNCH
#define SETATTR(M) okattr = okattr && (hipFuncSetAttribute((const void*)hybrid_mega<M>, hipFuncAttributeMaxDynamicSharedMemorySize, LDS_BYTES) == hipSuccess)
        SETATTR(0x001); SETATTR(0x002); SETATTR(0x004); SETATTR(0x008); SETATTR(0x010); SETATTR(0x020); SETATTR(0x040); SETATTR(0x080); SETATTR(0x100);
#else
        okattr = hipFuncSetAttribute((const void*)hybrid_mega<0xFFFF>, hipFuncAttributeMaxDynamicSharedMemorySize, LDS_BYTES) == hipSuccess;
#endif
        if (!okattr) { fprintf(stderr, "kernel_launch: hipFuncSetAttribute failed\n"); grid = -1; return; }
        int dev = 0, cus = 0, per_cu = 0;
        (void)hipGetDevice(&dev); (void)hipDeviceGetAttribute(&cus, hipDeviceAttributeMultiprocessorCount, dev);
#if !MULTI_LAUNCH
        (void)hipOccupancyMaxActiveBlocksPerMultiprocessor(&per_cu, (const void*)hybrid_mega<0xFFFF>, 512, LDS_BYTES);
        if (per_cu < 1) { fprintf(stderr, "kernel_launch: occupancy query says %d blocks per CU\n", per_cu); per_cu = 1; }
#endif
        (void)hipGetLastError();
        if (cus < 256) { fprintf(stderr, "kernel_launch: built for a 256-CU device (got %d CUs)\n", cus); grid = -1; return; }
        grid = 256;
    }
    if (grid < 0) return;
    Params p{};
    const float** pp = (const float**)&p;
    for (int i = 0; i < 25; ++i) pp[i] = (const float*)d_in[i];
    p.out = (float*)d_out; p.ws = (unsigned char*)d_ws;
#if MULTI_LAUNCH
    for (int ph = 0; ph < 34; ++ph) { p.ph_lo = ph; p.ph_hi = ph + 1;
        const int sub = (ph == 0) ? 8 : (ph == 33 ? 0 : ((ph - 1) & 7));
        switch (sub) {
#define LCH(K) case K: hipLaunchKernelGGL(hybrid_mega<(1 << K)>, dim3(grid), dim3(512), LDS_BYTES, stream, p); break
        LCH(0); LCH(1); LCH(2); LCH(3); LCH(4); LCH(5); LCH(6); LCH(7); LCH(8);
        } }
#else
    p.ph_lo = 0; p.ph_hi = 34;
    (void)hipMemsetAsync((unsigned char*)d_ws + WS_BAR, 0, 16384, stream);
    void* args[] = {&p};
    hipError_t e = hipLaunchCooperativeKernel((const void*)hybrid_mega<0xFFFF>, dim3(grid), dim3(512), args, LDS_BYTES, stream);
    if (e != hipSuccess) fprintf(stderr, "cooperative launch failed: %s (grid %d)\n", hipGetErrorString(e), grid);
#endif
}
```

```cpp
#include <hip/hip_runtime.h>
#include <hip/hip_cooperative_groups.h>
#include <cstdio>
namespace cg = cooperative_groups;

#ifndef MULTI_LAUNCH
#define MULTI_LAUNCH 0
#endif

#define LAS __attribute__((address_space(3)))
typedef unsigned short bf16_t;
typedef short bf16x8 __attribute__((ext_vector_type(8)));
typedef float f32x4 __attribute__((ext_vector_type(4)));
typedef unsigned u32x4 __attribute__((ext_vector_type(4)));

constexpr int DM = 2048, NBATCH = 4, SEQ = 4096, NCTX = 256;
constexpr int TLAT = NBATCH * SEQ, TCTX = NBATCH * NCTX, T = TLAT + TCTX;
constexpr int NIN = 14336;
constexpr int NCHUNK = T / 16;
constexpr int XROWS = 1280;
constexpr int LDS_BYTES = 131072 + 16;

constexpr size_t WS_WINT = 0;
constexpr size_t WS_WBRT = WS_WINT + (size_t)4 * NIN * DM * 2;
constexpr size_t WS_WOT  = WS_WBRT + (size_t)4 * DM * DM * 2;
constexpr size_t WS_GLUT = WS_WOT + (size_t)4 * DM * DM * 2;
constexpr size_t WS_MG   = WS_GLUT + (size_t)4 * 1024 * 512 * 2;
constexpr size_t WS_WG   = WS_MG + (size_t)4 * 32 * 256 * 512 * 2;
constexpr size_t WS_A16  = WS_WG + (size_t)4 * 32 * 256 * 256 * 2;
constexpr size_t WS_MOD  = WS_A16 + (size_t)4 * 2 * 32 * 64 * 2 * 4;
constexpr size_t WS_H    = WS_MOD + (size_t)4 * 5 * 6144 * 4;
constexpr size_t WS_PROJ = WS_H + (size_t)T * DM * 2;
constexpr size_t WS_VT   = WS_PROJ + (size_t)T * NIN * 2;
constexpr size_t WS_X    = WS_VT + (size_t)512 * T * 2;
constexpr size_t WS_E    = WS_X + (size_t)32 * XROWS * 512 * 2;
constexpr size_t WS_G    = WS_E + (size_t)32 * XROWS * 256 * 4;
constexpr size_t WS_U    = WS_G + (size_t)T * 512 * 2;
constexpr size_t WS_MRG  = WS_U + (size_t)T * DM * 2;
constexpr size_t WS_Y    = WS_MRG + (size_t)T * DM * 2;
constexpr size_t WS_XC   = WS_Y + (size_t)T * DM * 4;
constexpr size_t WS_BAR  = WS_XC + (size_t)TCTX * DM * 4;
constexpr size_t WS_R    = WS_BAR + 16384;
constexpr size_t WS_END  = WS_R + (size_t)4 * T * DM * 2;

struct Params {
    const float *x, *c, *ctx, *c_ctx, *w_mod, *b_mod, *g_pre, *g_post, *w_in, *b_gate, *na_rpb, *pool_w, *pool_scale, *conv_w,
        *a_re, *a_im, *log_dt, *b_re, *b_im, *c_re, *c_im, *ssm_d, *glu_w, *w_br, *w_o;
    float* out; unsigned char* ws; int ph_lo, ph_hi;
};

typedef const __attribute__((address_space(4))) Params* PP;

typedef float f32x2_t __attribute__((ext_vector_type(2)));
typedef __bf16 bf16x2_t __attribute__((ext_vector_type(2)));
__device__ __forceinline__ unsigned cvt_pk_bf16(float lo, float hi) { const f32x2_t f = {lo, hi}; const bf16x2_t b = __builtin_convertvector(f, bf16x2_t); unsigned r; __builtin_memcpy(&r, &b, 4); return r; }
__device__ __forceinline__ bf16_t f2bf(float f) { unsigned u = __float_as_uint(f); u += 0x7FFFu + ((u >> 16) & 1u); return (bf16_t)(u >> 16); }
__device__ __forceinline__ float bf2f(bf16_t b) { return __uint_as_float(((unsigned)b) << 16); }
__device__ __forceinline__ float bflo(unsigned w) { return __uint_as_float(w << 16); }
__device__ __forceinline__ float bfhi(unsigned w) { return __uint_as_float(w & 0xFFFF0000u); }
__device__ __forceinline__ float sigmoidf_(float x) { return __builtin_amdgcn_rcpf(1.0f + __builtin_amdgcn_exp2f(-1.4426950408889634f * x)); }
__device__ __forceinline__ float siluf_(float x) { return x * sigmoidf_(x); }
__device__ __forceinline__ float gelu_tanh(float y) { const float u = 0.7978845608028654f * (y + 0.044715f * y * y * y); return y * sigmoidf_(2.0f * u); }
__device__ __forceinline__ void unpack8(const u32x4 w, float (&f)[8]) { f[0] = bflo(w.x); f[1] = bfhi(w.x); f[2] = bflo(w.y); f[3] = bfhi(w.y); f[4] = bflo(w.z); f[5] = bfhi(w.z); f[6] = bflo(w.w); f[7] = bfhi(w.w); }
__device__ __forceinline__ u32x4 pack8(const float (&f)[8]) { u32x4 w; w.x = cvt_pk_bf16(f[0], f[1]); w.y = cvt_pk_bf16(f[2], f[3]); w.z = cvt_pk_bf16(f[4], f[5]); w.w = cvt_pk_bf16(f[6], f[7]); return w; }

__device__ __forceinline__ int opaque_tid() { int t = threadIdx.x; asm volatile("" : "+v"(t)); return t; }

namespace pg8 {
constexpr int BM = 256, BK = 64, HALF = 128, HTB = HALF * BK * 2, STAGE_BYTES = 8 * HTB, NXCD = 8, WGM = 4;
__device__ __forceinline__ int lds_byte(int r, int c) { const int st = (r >> 4) * 2 + (c >> 5), rr = r & 15, cc = c & 31, ob = rr * 64 + cc * 2; return st * 1024 + (ob ^ (((ob >> 9) & 1) << 5)); }
__device__ __forceinline__ void stage_rc(int b, int& R, int& C) { const int st = b / 1024, sb = b % 1024, swz = sb ^ (((sb >> 9) & 1) << 5); R = (st >> 1) * 16 + swz / 64; C = (st & 1) * 32 + (swz % 64) / 2; }
__device__ __forceinline__ int perm32(int rho) { const int n = rho >> 4, i = rho & 15; return 8 * (i >> 2) + 4 * n + (i & 3); }

struct Unit { const char* a; const char* b; int pm, pn, kind; };
struct Gemm { int lda, ldb, K; };

__device__ __forceinline__ void swz_tile(int L, int nM, int nN, int& pm, int& pn) {
    const int nwg = nM * nN; int wgid = L;
    { const int q = nwg / NXCD, r = nwg % NXCD, xcd = wgid % NXCD, off = wgid / NXCD; wgid = (xcd < r ? xcd * (q + 1) : r * (q + 1) + (xcd - r) * q) + off; }
    const int nig = WGM * nN, gid = wgid / nig, fm = gid * WGM, gsz = (nM - fm) < WGM ? (nM - fm) : WGM;
    pm = fm + ((wgid % nig) % gsz); pn = (wgid % nig) / gsz;
}

template <class Epi, class Sched>
__device__ __forceinline__ void gemm_phase(LAS unsigned char* lds, const Gemm g, const Sched& S, const Epi& E) {
    const int tid = opaque_tid(), wid = __builtin_amdgcn_readfirstlane(tid >> 6), lane = tid & 63, wr = wid >> 2, wc = wid & 3, fr = lane & 15, fq = lane >> 4;
    int K = g.K; asm volatile("" : "+s"(K)); const int nt = K / BK;
    unsigned voffA[2], voffB[2];
#pragma unroll
    for (int i = 0; i < 2; ++i) { int R, C; stage_rc(tid * 16 + i * 8192, R, C); const int Rb = Epi::PERM ? ((R & ~31) + perm32(R & 31)) : R;
        voffA[i] = (unsigned)(R * g.lda + C) * 2u; voffB[i] = (unsigned)(Rb * g.ldb + C) * 2u; }
    const size_t kstep = (size_t)(BK * 2);
    const size_t hstepA = (size_t)HALF * g.lda * 2, hstepB = (size_t)HALF * g.ldb * 2;
    const unsigned ldsw = (unsigned)wid * 1024u;
    const int aoff = lds_byte(wr * 64 + fr, fq * 8), boff = lds_byte(wc * 32 + fr, fq * 8);
#define PG8_SA(b, h) (((b) * 2 + (h)) * HTB)
#define PG8_SB(b, h) ((4 + (b) * 2 + (h)) * HTB)
#define PG8_STAGE(bufoff, gbase, voff) do { _Pragma("unroll") for (int _i = 0; _i < 2; ++_i) \
        __builtin_amdgcn_global_load_lds((const unsigned*)((const char*)(gbase) + (voff)[_i]), (LAS unsigned*)(lds + (bufoff) + ldsw + _i * 8192), 16, 0, 0); } while (0)
#define PG8_LDA(dst, b, h) do { _Pragma("unroll") for (int m = 0; m < 4; ++m) _Pragma("unroll") for (int k = 0; k < 2; ++k) dst[m][k] = *(const LAS bf16x8*)(lds + PG8_SA(b, h) + aoff + m * 2048 + k * 1024); } while (0)
#define PG8_LDB(dst, b, h) do { _Pragma("unroll") for (int n = 0; n < 2; ++n) _Pragma("unroll") for (int k = 0; k < 2; ++k) dst[n][k] = *(const LAS bf16x8*)(lds + PG8_SB(b, h) + boff + n * 2048 + k * 1024); } while (0)
#define PG8_MMA(ai, bj, At, Bt) do { __builtin_amdgcn_s_setprio(1); _Pragma("unroll") for (int m = 0; m < 4; ++m) _Pragma("unroll") for (int n = 0; n < 2; ++n) _Pragma("unroll") for (int k = 0; k < 2; ++k) \
        acc[ai][bj][m][n] = __builtin_amdgcn_mfma_f32_16x16x32_bf16(Bt[n][k], At[m][k], acc[ai][bj][m][n], 0, 0, 0); __builtin_amdgcn_s_setprio(0); } while (0)
#ifdef SAFE_WAITS
#define PG8_WAIT_V(n) asm volatile("s_waitcnt vmcnt(0)" ::: "memory")
#else
#define PG8_WAIT_V(n) asm volatile("s_waitcnt vmcnt(" #n ")" ::: "memory")
#endif
#ifdef SAFE_WAITS
#define PG8_WAIT_L(n) asm volatile("s_waitcnt lgkmcnt(0)" ::: "memory")
#else
#define PG8_WAIT_L(n) asm volatile("s_waitcnt lgkmcnt(" #n ")" ::: "memory")
#endif
#define PG8_BAR do { __builtin_amdgcn_sched_barrier(0); __builtin_amdgcn_s_barrier(); __builtin_amdgcn_sched_barrier(0); } while (0)
#define PG8_SCHED __builtin_amdgcn_sched_barrier(0)
    Unit cur, nxt; int ui = 0;
    if (!S.next(0, cur)) return;
    f32x4 acc[2][2][4][2];
#pragma unroll
    for (int a = 0; a < 2; ++a)
#pragma unroll
        for (int b = 0; b < 2; ++b)
#pragma unroll
            for (int m = 0; m < 4; ++m)
#pragma unroll
                for (int n = 0; n < 2; ++n) acc[a][b][m][n] = (f32x4){0.f, 0.f, 0.f, 0.f};
    bf16x8 At[4][2], B0[2][2], B1[2][2];
#ifdef SYNC_GEMM
    const char* cA = cur.a; const char* cB = cur.b;
    for (;;) {
        const bool has_next = S.next(ui + 1, nxt);
        for (int t = 0; t < nt; ++t) {
            if constexpr (Epi::SEG) { if (t != 0 && (t & 7) == 0) E.segment(acc, cur, t >> 3, wr, wc, fr, fq); }
            const char* at = cA + (size_t)t * kstep; const char* bt = cB + (size_t)t * kstep;
            PG8_BAR;
            PG8_STAGE(PG8_SB(0, 0), bt, voffB); PG8_STAGE(PG8_SA(0, 0), at, voffA); PG8_STAGE(PG8_SB(0, 1), bt + hstepB, voffB); PG8_STAGE(PG8_SA(0, 1), at + hstepA, voffA);
            PG8_WAIT_V(0); PG8_BAR;
            PG8_LDB(B0, 0, 0); PG8_LDB(B1, 0, 1); PG8_LDA(At, 0, 0); PG8_WAIT_L(0); PG8_MMA(0, 0, At, B0); PG8_MMA(0, 1, At, B1);
            PG8_LDA(At, 0, 1); PG8_WAIT_L(0); PG8_MMA(1, 0, At, B0); PG8_MMA(1, 1, At, B1);
        }
        E(acc, cur, wr, wc, fr, fq);
        if (!has_next) break;
#pragma unroll
        for (int a = 0; a < 2; ++a)
#pragma unroll
            for (int b = 0; b < 2; ++b)
#pragma unroll
                for (int m = 0; m < 4; ++m)
#pragma unroll
                    for (int n = 0; n < 2; ++n) acc[a][b][m][n] = (f32x4){0.f, 0.f, 0.f, 0.f};
        cur = nxt; cA = cur.a; cB = cur.b; ++ui;
    }
    PG8_WAIT_V(0);
    PG8_BAR;
#else
    const char* cA = cur.a; const char* cB = cur.b;
    PG8_STAGE(PG8_SB(0, 0), cB, voffB); PG8_STAGE(PG8_SA(0, 0), cA, voffA); PG8_STAGE(PG8_SB(0, 1), cB + hstepB, voffB); PG8_STAGE(PG8_SA(0, 1), cA + hstepA, voffA);
    if (wr == 1) PG8_BAR;
    PG8_WAIT_V(4); PG8_BAR;
    PG8_STAGE(PG8_SB(1, 0), cB + kstep, voffB); PG8_STAGE(PG8_SA(1, 0), cA + kstep, voffA); PG8_STAGE(PG8_SB(1, 1), cB + hstepB + kstep, voffB);
    PG8_WAIT_V(6); PG8_BAR;
    for (;;) {
        const bool has_next = S.next(ui + 1, nxt);
        const char* nA = has_next ? nxt.a : cA; const char* nB = has_next ? nxt.b : cB;
        for (int t = 0; t < nt; t += 2) {
            const bool last = (t == nt - 2);
            if constexpr (Epi::SEG) { if (t != 0 && (t & 7) == 0) E.segment(acc, cur, t >> 3, wr, wc, fr, fq); }
            const char* a1 = cA + (size_t)(t + 1) * kstep;
            const char* a2 = last ? nA : cA + (size_t)(t + 2) * kstep; const char* b2 = last ? nB : cB + (size_t)(t + 2) * kstep;
            const char* a3 = a2 + kstep; const char* b3 = b2 + kstep;
            PG8_LDB(B0, 0, 0); PG8_SCHED; PG8_LDA(At, 0, 0); PG8_STAGE(PG8_SA(1, 1), a1 + hstepA, voffA);
            PG8_WAIT_L(8); PG8_BAR; PG8_WAIT_L(0); PG8_MMA(0, 0, At, B0); PG8_BAR; PG8_SCHED;
            PG8_LDB(B1, 0, 1); PG8_STAGE(PG8_SB(0, 0), b2, voffB);
            PG8_BAR; PG8_WAIT_L(0); PG8_MMA(0, 1, At, B1); PG8_BAR;
            PG8_LDA(At, 0, 1); PG8_STAGE(PG8_SA(0, 0), a2, voffA);
            PG8_BAR; PG8_WAIT_L(0); PG8_MMA(1, 0, At, B0); PG8_BAR; PG8_SCHED;
            PG8_STAGE(PG8_SB(0, 1), b2 + hstepB, voffB);
            PG8_WAIT_V(6); PG8_BAR; PG8_MMA(1, 1, At, B1); PG8_BAR;
            PG8_LDB(B0, 1, 0); PG8_SCHED; PG8_LDA(At, 1, 0); PG8_STAGE(PG8_SA(0, 1), a2 + hstepA, voffA);
            PG8_WAIT_L(8); PG8_BAR; PG8_WAIT_L(0); PG8_MMA(0, 0, At, B0); PG8_BAR; PG8_SCHED;
            PG8_LDB(B1, 1, 1); PG8_STAGE(PG8_SB(1, 0), b3, voffB);
            PG8_BAR; PG8_WAIT_L(0); PG8_MMA(0, 1, At, B1); PG8_BAR;
            PG8_LDA(At, 1, 1); PG8_STAGE(PG8_SA(1, 0), a3, voffA);
            PG8_BAR; PG8_WAIT_L(0); PG8_MMA(1, 0, At, B0); PG8_BAR; PG8_SCHED;
            PG8_STAGE(PG8_SB(1, 1), b3 + hstepB, voffB);
            PG8_WAIT_V(6); PG8_BAR; PG8_MMA(1, 1, At, B1); PG8_BAR;
        }
        E(acc, cur, wr, wc, fr, fq);
        if (!has_next) break;
#pragma unroll
        for (int a = 0; a < 2; ++a)
#pragma unroll
            for (int b = 0; b < 2; ++b)
#pragma unroll
                for (int m = 0; m < 4; ++m)
#pragma unroll
                    for (int n = 0; n < 2; ++n) acc[a][b][m][n] = (f32x4){0.f, 0.f, 0.f, 0.f};
        cur = nxt; cA = nA; cB = nB; ++ui;
    }
    PG8_WAIT_V(0);
    if (wr == 0) PG8_BAR;
    PG8_BAR;
#endif
#undef PG8_SA
#undef PG8_SB
#undef PG8_STAGE
#undef PG8_LDA
#undef PG8_LDB
#undef PG8_MMA
#undef PG8_WAIT_V
#undef PG8_WAIT_L
#undef PG8_BAR
#undef PG8_SCHED
}
}
using pg8::Unit;
typedef f32x4 Acc[2][2][4][2];

struct OrderInproj {
    const char* W; const char* H; int G, c;
    __device__ __forceinline__ bool next(int i, Unit& u) const {
        const int L = i * G + c; constexpr int NMAIN = 68 * 54;
        if (L >= NMAIN + 136) return false;
        if (L < NMAIN) { int pm, pn; pg8::swz_tile(L, 68, 54, pm, pn); if (pn >= 4) pn += 2;
            u.a = H + (size_t)pm * 256 * DM * 2; u.b = W + (size_t)pn * 256 * DM * 2; u.pm = pm; u.pn = pn; u.kind = 0; }
        else { const int v = L - NMAIN, pm = v & 1, pn = v >> 1;
            u.a = W + (size_t)(1024 + pm * 256) * DM * 2; u.b = H + (size_t)pn * 256 * DM * 2; u.pm = pm; u.pn = pn; u.kind = 1; }
        return true;
    }
};
struct OrderSimple {
    const char* A; const char* B; int nM, nN, lda, ldb, G, c;
    __device__ __forceinline__ bool next(int i, Unit& u) const {
        const int L = i * G + c; if (L >= nM * nN) return false;
        int pm, pn; pg8::swz_tile(L, nM, nN, pm, pn);
        u.a = A + (size_t)pm * 256 * lda * 2; u.b = B + (size_t)pn * 256 * ldb * 2; u.pm = pm; u.pn = pn; u.kind = 0; return true;
    }
};
struct OrderGroup {
    const char* X; const char* Mt; int ldb, G, c;
    __device__ __forceinline__ bool next(int i, Unit& u) const {
        const int L = i * G + c; if (L >= 160) return false;
        const int g = L / 5, r = L - g * 5;
        u.a = X + ((size_t)(g * XROWS + r * 256) * 512) * 2; u.b = Mt + (size_t)g * 256 * ldb * 2; u.pm = r; u.pn = g; u.kind = 0; return true;
    }
};

struct EpiInproj {
    static constexpr bool PERM = true, SEG = false;
    bf16_t* proj; bf16_t* vt; bf16_t* X; const float* bgate; bf16_t* R;
    __device__ __forceinline__ void operator()(const Acc& acc, const Unit& u, int wr, int wc, int fr, int fq) const {
        const int row0 = u.pm * 256 + wr * 64 + fr, col0 = u.pn * 256 + wc * 32 + 8 * fq;
        if (u.kind == 1) {
#pragma unroll
            for (int ai = 0; ai < 2; ++ai)
#pragma unroll
                for (int m = 0; m < 4; ++m) { bf16_t* rowp = vt + (size_t)(row0 + ai * 128 + m * 16) * T + col0;
#pragma unroll
                    for (int bj = 0; bj < 2; ++bj) { const f32x4 v0 = acc[ai][bj][m][0], v1 = acc[ai][bj][m][1]; u32x4 w;
                        w.x = cvt_pk_bf16(v0[0], v0[1]); w.y = cvt_pk_bf16(v0[2], v0[3]); w.z = cvt_pk_bf16(v1[0], v1[1]); w.w = cvt_pk_bf16(v1[2], v1[3]);
                        *(u32x4*)(rowp + bj * 128) = w; } }
            return;
        }
        const int pn = u.pn;
        if (pn >= 24) {
            const int ch0 = (pn - 24) * 64 + wc * 16 + fq * 4;
            f32x4 bgv[4];
#pragma unroll
            for (int br = 0; br < 4; ++br) bgv[br] = *(const f32x4*)(bgate + br * DM + ch0);
#pragma unroll
            for (int ai = 0; ai < 2; ++ai)
#pragma unroll
                for (int m = 0; m < 4; ++m) { const int row = row0 + ai * 128 + m * 16; f32x4 g[4], d[4];
                    const int cl = ch0 & 255, rl = row & 255;
                    const size_t roff = ((((((size_t)((row >> 8) * 8 + (ch0 >> 8)) * 2 + (rl >> 7)) * 4 + ((rl >> 4) & 3)) * 2 + (cl >> 7)) * 8 + (((rl >> 6) & 1) * 4 + ((cl >> 5) & 3))) * 64
                                         + ((rl & 15) + 16 * ((cl >> 3) & 3))) * 8 + (cl & 7);
#pragma unroll
                    for (int br = 0; br < 4; ++br)
#pragma unroll
                        for (int j = 0; j < 4; ++j) { d[br][j] = fminf(1.0f + __builtin_amdgcn_exp2f(-1.4426950408889634f * (acc[ai][br >> 1][m][br & 1][j] + bgv[br][j])), 1e30f); g[br][j] = __builtin_amdgcn_rcpf(d[br][j]); }
#pragma unroll
                    for (int k = 0; k < 4; ++k) { f32x4 r = g[k];
                        if (k < 3) {
#pragma unroll
                            for (int j = 0; j < 4; ++j) r[j] = g[k][j] * d[k + 1][j]; }
                        uint2 w; w.x = cvt_pk_bf16(r[0], r[1]); w.y = cvt_pk_bf16(r[2], r[3]);
                        *(uint2*)(R + (size_t)k * T * DM + roff) = w; } }
            return;
        }
        int mode = 0;
        if (pn < 2) mode = 1; else if (pn == 6 || pn == 7 || pn == 10 || pn == 11 || pn == 18 || pn == 19 || pn == 22 || pn == 23) mode = 2;
        else if (pn == 20 || pn == 21) mode = 3; else if (pn >= 24) mode = 4;
#pragma unroll
        for (int bj = 0; bj < 2; ++bj) {
            const int col = col0 + bj * 128;
            float bg[8];
#pragma unroll
            for (int e = 0; e < 8; ++e) bg[e] = 0.f;
            if (mode == 4) { const f32x4 b0 = *(const f32x4*)(bgate + col - 6144), b1 = *(const f32x4*)(bgate + col - 6144 + 4);
#pragma unroll
                for (int e = 0; e < 4; ++e) { bg[e] = b0[e]; bg[4 + e] = b1[e]; } }
#pragma unroll
            for (int ai = 0; ai < 2; ++ai)
#pragma unroll
                for (int m = 0; m < 4; ++m) {
                    const int row = row0 + ai * 128 + m * 16;
                    float v[8];
#pragma unroll
                    for (int e = 0; e < 4; ++e) { v[e] = acc[ai][bj][m][0][e]; v[4 + e] = acc[ai][bj][m][1][e]; }
                    if (mode == 1) {
#pragma unroll
                        for (int e = 0; e < 8; ++e) v[e] *= 0.125f;
                    } else if (mode == 2) {
#pragma unroll
                        for (int e = 0; e < 8; ++e) v[e] = siluf_(v[e]);
                    } else if (mode == 4) {
#pragma unroll
                        for (int e = 0; e < 8; ++e) v[e] = sigmoidf_(v[e] + bg[e]);
                    }
                    const u32x4 w = pack8(v);
                    if (mode == 3) { const int cc = col - 5120, g = cc >> 4, h0 = cc & 15, n = row >> 4, j = row & 15;
                        *(u32x4*)(X + ((size_t)(g * XROWS + n) * 512 + j * 16 + h0)) = w; }
                    else *(u32x4*)(proj + (size_t)row * NIN + col) = w;
                }
        }
    }
};
struct EpiE {
    static constexpr bool PERM = false, SEG = false;
    float* E;
    __device__ __forceinline__ void operator()(const Acc& acc, const Unit& u, int wr, int wc, int fr, int fq) const {
        const int g = u.pn, row0 = u.pm * 256 + wr * 64 + fr, col0 = wc * 32 + 4 * fq;
#pragma unroll
        for (int ai = 0; ai < 2; ++ai)
#pragma unroll
            for (int m = 0; m < 4; ++m) { const int n = row0 + ai * 128 + m * 16; if (n < NCHUNK) { float* rowp = E + (size_t)(g * XROWS + n) * 256 + col0;
#pragma unroll
                for (int bj = 0; bj < 2; ++bj)
#pragma unroll
                    for (int nn = 0; nn < 2; ++nn) *(f32x4*)(rowp + bj * 128 + nn * 16) = acc[ai][bj][m][nn]; } }
    }
};
struct EpiY {
    static constexpr bool PERM = true, SEG = false;
    bf16_t* Gb;
    __device__ __forceinline__ void operator()(const Acc& acc, const Unit& u, int wr, int wc, int fr, int fq) const {
        const int g = u.pn, row0 = u.pm * 256 + wr * 64 + fr, col0 = wc * 32 + 8 * fq;
#pragma unroll
        for (int ai = 0; ai < 2; ++ai)
#pragma unroll
            for (int m = 0; m < 4; ++m) { const int n = row0 + ai * 128 + m * 16; if (n < NCHUNK) {
#pragma unroll
                for (int bj = 0; bj < 2; ++bj) { const int col = col0 + bj * 128, t = col >> 4, h0 = col & 15; float v[8];
#pragma unroll
                    for (int e = 0; e < 4; ++e) { v[e] = gelu_tanh(acc[ai][bj][m][0][e]); v[4 + e] = gelu_tanh(acc[ai][bj][m][1][e]); }
                    *(u32x4*)(Gb + (size_t)(n * 16 + t) * 512 + g * 16 + h0) = pack8(v); } } }
    }
};
struct EpiGlu {
    static constexpr bool PERM = true, SEG = false;
    const bf16_t* proj; bf16_t* U;
    __device__ __forceinline__ void operator()(const Acc& acc, const Unit& u, int wr, int wc, int fr, int fq) const {
        const int row0 = u.pm * 256 + wr * 64 + fr, col = u.pn * 128 + wc * 32 + 8 * fq;
#pragma unroll
        for (int ai = 0; ai < 2; ++ai)
#pragma unroll
            for (int m = 0; m < 4; ++m) { const int row = row0 + ai * 128 + m * 16;
                float z[8]; unpack8(*(const u32x4*)(proj + (size_t)row * NIN + 5632 + col), z);
                float v[8];
#pragma unroll
                for (int e = 0; e < 4; ++e) { v[e] = acc[ai][0][m][0][e] * sigmoidf_(acc[ai][1][m][0][e]) * z[e]; v[4 + e] = acc[ai][0][m][1][e] * sigmoidf_(acc[ai][1][m][1][e]) * z[4 + e]; }
                *(u32x4*)(U + (size_t)row * DM + 1536 + col) = pack8(v); }
    }
};
struct EpiBranch {
    static constexpr bool PERM = true, SEG = true;
    const bf16_t* R; bf16_t* mrg;
    __device__ __forceinline__ void segment(Acc& acc, const Unit& u, int seg, int wr, int wc, int fr, int fq) const {
        int loff = (((wr * 4 + wc) * 64) + fr + 16 * fq) * 8;
        asm volatile("" : "+v"(loff));
        const bf16_t* rbase = R + (size_t)(seg - 1) * T * DM + (size_t)(u.pm * 8 + u.pn) * 65536 + loff;
        u32x4 rr[2][4][2];
#pragma unroll
        for (int ai = 0; ai < 2; ++ai)
#pragma unroll
            for (int m = 0; m < 4; ++m)
#pragma unroll
                for (int bj = 0; bj < 2; ++bj) rr[ai][m][bj] = *(const u32x4*)(rbase + ((ai * 4 + m) * 2 + bj) * 4096);
#pragma unroll
        for (int ai = 0; ai < 2; ++ai)
#pragma unroll
            for (int m = 0; m < 4; ++m)
#pragma unroll
                for (int bj = 0; bj < 2; ++bj) { float r[8]; unpack8(rr[ai][m][bj], r);
#pragma unroll
                    for (int e = 0; e < 4; ++e) { acc[ai][bj][m][0][e] *= r[e]; acc[ai][bj][m][1][e] *= r[4 + e]; } }
        __builtin_amdgcn_sched_barrier(0);
    }
    __device__ __forceinline__ void operator()(const Acc& acc, const Unit& u, int wr, int wc, int fr, int fq) const {
        const int row0 = u.pm * 256 + wr * 64 + fr, col0 = u.pn * 256 + wc * 32 + 8 * fq;
        const bf16_t* gbase = R + (size_t)3 * T * DM + (size_t)(u.pm * 8 + u.pn) * 65536 + (((wr * 4 + wc) * 64) + fr + 16 * fq) * 8;
#pragma unroll
        for (int ai = 0; ai < 2; ++ai)
#pragma unroll
            for (int m = 0; m < 4; ++m) { const int row = row0 + ai * 128 + m * 16;
#pragma unroll
                for (int bj = 0; bj < 2; ++bj) { float ga[8], v[8]; unpack8(*(const u32x4*)(gbase + ((ai * 4 + m) * 2 + bj) * 4096), ga);
#pragma unroll
                    for (int e = 0; e < 4; ++e) { v[e] = acc[ai][bj][m][0][e] * ga[e]; v[4 + e] = acc[ai][bj][m][1][e] * ga[4 + e]; }
                    *(u32x4*)(mrg + (size_t)row * DM + col0 + bj * 128) = pack8(v); } }
    }
};
struct EpiWo {
    static constexpr bool PERM = true, SEG = false;
    bf16_t* Y;
    __device__ __forceinline__ void operator()(const Acc& acc, const Unit& u, int wr, int wc, int fr, int fq) const {
        const int row0 = u.pm * 256 + wr * 64 + fr, col0 = u.pn * 256 + wc * 32 + 8 * fq;
#pragma unroll
        for (int ai = 0; ai < 2; ++ai)
#pragma unroll
            for (int m = 0; m < 4; ++m) { bf16_t* rowp = Y + (size_t)(row0 + ai * 128 + m * 16) * DM + col0;
#pragma unroll
                for (int bj = 0; bj < 2; ++bj) { const f32x4 v0 = acc[ai][bj][m][0], v1 = acc[ai][bj][m][1]; u32x4 w;
                    w.x = cvt_pk_bf16(v0[0], v0[1]); w.y = cvt_pk_bf16(v0[2], v0[3]); w.z = cvt_pk_bf16(v1[0], v1[1]); w.w = cvt_pk_bf16(v1[2], v1[3]);
                    *(u32x4*)(rowp + bj * 128) = w; } }
    }
};

__device__ void job_mod(PP p, unsigned char* smem, int job) {
    const int tid = opaque_tid(), layer = job / 48, col0 = (job % 48) * 128;
    float* cact = (float*)smem;
    float* red = cact + 5 * 2048;
    for (int i = tid; i < 5 * 2048; i += 512) { const int r = i >> 11, k = i & 2047; const float v = r < 4 ? p->c[r * 2048 + k] : p->c_ctx[k]; cact[i] = siluf_(v); }
    __syncthreads();
    const int cgp = tid & 31, ks = tid >> 5;
    float acc[5][4];
#pragma unroll
    for (int r = 0; r < 5; ++r)
#pragma unroll
        for (int j = 0; j < 4; ++j) acc[r][j] = 0.f;
    const float* wp = p->w_mod + (size_t)layer * 2048 * 6144 + col0 + cgp * 4;
#pragma unroll 4
    for (int k = ks; k < 2048; k += 16) { const f32x4 w = *(const f32x4*)(wp + (size_t)k * 6144);
#pragma unroll
        for (int r = 0; r < 5; ++r) { const float a = cact[r * 2048 + k];
#pragma unroll
            for (int j = 0; j < 4; ++j) acc[r][j] += a * w[j]; } }
#pragma unroll
    for (int r = 0; r < 5; ++r)
#pragma unroll
        for (int j = 0; j < 4; ++j) red[(ks * 5 + r) * 128 + cgp * 4 + j] = acc[r][j];
    __syncthreads();
    float* mod = (float*)(p->ws + WS_MOD);
    for (int o = tid; o < 640; o += 512) { const int r = o >> 7, cl = o & 127; float s = 0.f;
        for (int q = 0; q < 16; ++q) s += red[(q * 5 + r) * 128 + cl];
        mod[(size_t)(layer * 5 + r) * 6144 + col0 + cl] = s + p->b_mod[layer * 6144 + col0 + cl]; }
    __syncthreads();
}

__device__ void job_ssm(PP p, unsigned char* smem, int job) {
    const int tid = opaque_tid(), layer = job >> 5, g = job & 31;
    float* pw = (float*)smem;
    float* bb = pw + 2 * 17 * 64 * 2;
    float* cc = bb + 2 * 64 * 16 * 2;
    float* kk = cc + 2 * 16 * 64 * 2;
    float* dsk = kk + 2 * 16 * 16 * 16;
    if (tid < 128) {
        const int dir = tid >> 6, pp = tid & 63; const int idx = ((layer * 2 + dir) * 32 + g) * 64 + pp;
        const float are = p->a_re[idx], aim = p->a_im[idx], dt = expf(p->log_dt[(layer * 2 + dir) * 32 + g]);
        const float ex1 = are * dt, ang1 = aim * dt;
        for (int k = 0; k <= 16; ++k) { const float mag = expf(ex1 * (float)k), ang = ang1 * (float)k; const float kq = rintf(ang * 0.15915494309189535f);
            float rr = fmaf(-kq, 6.2831854820251465f, ang); rr = fmaf(-kq, -1.7484555e-7f, rr);
            pw[((dir * 17 + k) * 64 + pp) * 2 + 0] = mag * cosf(rr); pw[((dir * 17 + k) * 64 + pp) * 2 + 1] = mag * sinf(rr); }
        const float abr = pw[((dir * 17 + 1) * 64 + pp) * 2], abi = pw[((dir * 17 + 1) * 64 + pp) * 2 + 1];
        const float nr = abr - 1.0f, ni = abi, den = are * are + aim * aim;
        const float fre = (nr * are + ni * aim) / den, fim = (ni * are - nr * aim) / den;
        for (int h = 0; h < 16; ++h) { const float br = p->b_re[(size_t)idx * 16 + h], bi = p->b_im[(size_t)idx * 16 + h];
            bb[((dir * 64 + pp) * 16 + h) * 2 + 0] = fre * br - fim * bi; bb[((dir * 64 + pp) * 16 + h) * 2 + 1] = fre * bi + fim * br; }
        float* a16 = (float*)(p->ws + WS_A16);
        a16[(size_t)idx * 2 + 0] = pw[((dir * 17 + 16) * 64 + pp) * 2]; a16[(size_t)idx * 2 + 1] = pw[((dir * 17 + 16) * 64 + pp) * 2 + 1];
    }
    for (int i = tid; i < 2048; i += 512) { const int dir = i >> 10, h = (i >> 6) & 15, pp = i & 63; const size_t src = ((size_t)((layer * 2 + dir) * 32 + g) * 16 + h) * 64 + pp;
        cc[i * 2] = p->c_re[src]; cc[i * 2 + 1] = p->c_im[src]; }
    if (tid < 16) dsk[tid] = p->ssm_d[layer * 512 + g * 16 + tid];
    __syncthreads();
    {
        const int dir = tid >> 8, k = (tid >> 4) & 15, h = tid & 15;
        float acc[16];
#pragma unroll
        for (int e = 0; e < 16; ++e) acc[e] = 0.f;
        for (int pp = 0; pp < 64; ++pp) { const float cr = cc[((dir * 16 + h) * 64 + pp) * 2], ci = cc[((dir * 16 + h) * 64 + pp) * 2 + 1];
            const float ar = pw[((dir * 17 + k) * 64 + pp) * 2], ai = pw[((dir * 17 + k) * 64 + pp) * 2 + 1];
            const float car = cr * ar - ci * ai, cai = cr * ai + ci * ar;
#pragma unroll
            for (int e = 0; e < 16; ++e) acc[e] += car * bb[((dir * 64 + pp) * 16 + e) * 2] - cai * bb[((dir * 64 + pp) * 16 + e) * 2 + 1]; }
#pragma unroll
        for (int e = 0; e < 16; ++e) kk[((dir * 16 + k) * 16 + h) * 16 + e] = acc[e];
    }
    __syncthreads();
    bf16_t* Mg = (bf16_t*)(p->ws + WS_MG) + (size_t)(layer * 32 + g) * 256 * 512;
    for (int s = tid; s < 16384; s += 512) {
        const int row = s >> 6, col = (s & 63) * 8, t = row >> 4, h = row & 15; float v[8];
        if (col < 256) { const int j = col >> 4, h0 = col & 15;
#pragma unroll
            for (int e = 0; e < 8; ++e) { const int hp = h0 + e; float val = 0.f;
                if (j <= t) val += kk[((0 * 16 + (t - j)) * 16 + h) * 16 + hp];
                if (j >= t) val += kk[((1 * 16 + (j - t)) * 16 + h) * 16 + hp];
                if (j == t && hp == h) val += dsk[h];
                v[e] = val; } }
        else { const int dir = col >= 384 ? 1 : 0, pc = col - 256 - dir * 128, ri = pc >> 6, p0 = pc & 63, pwk = dir ? 16 - t : t + 1;
#pragma unroll
            for (int e = 0; e < 8; ++e) { const int pp = p0 + e; const float cr = cc[((dir * 16 + h) * 64 + pp) * 2], ci = cc[((dir * 16 + h) * 64 + pp) * 2 + 1];
                const float ar = pw[((dir * 17 + pwk) * 64 + pp) * 2], ai = pw[((dir * 17 + pwk) * 64 + pp) * 2 + 1];
                v[e] = ri ? -(cr * ai + ci * ar) : (cr * ar - ci * ai); } }
        *(u32x4*)(Mg + (size_t)row * 512 + col) = pack8(v);
    }
    bf16_t* Wg = (bf16_t*)(p->ws + WS_WG) + (size_t)(layer * 32 + g) * 256 * 256;
    for (int s = tid; s < 8192; s += 512) {
        const int row = s >> 5, col = (s & 31) * 8, dir = row >> 7, ri = (row >> 6) & 1, pp = row & 63, j = col >> 4, h0 = col & 15, ek = dir ? j : 15 - j;
        const float ar = pw[((dir * 17 + ek) * 64 + pp) * 2], ai = pw[((dir * 17 + ek) * 64 + pp) * 2 + 1]; float v[8];
#pragma unroll
        for (int e = 0; e < 8; ++e) { const float br = bb[((dir * 64 + pp) * 16 + h0 + e) * 2], bi = bb[((dir * 64 + pp) * 16 + h0 + e) * 2 + 1];
            v[e] = ri ? (ar * bi + ai * br) : (ar * br - ai * bi); }
        *(u32x4*)(Wg + (size_t)row * 256 + col) = pack8(v);
    }
    __syncthreads();
}

__device__ void job_fold(PP p, unsigned char* smem, int job) {
    const int tid = opaque_tid(), layer = job >> 7, gi = (job >> 5) & 3, k0 = (job & 31) * 64;
    float* wt = (float*)smem;
    float* pl = wt + 64 * 128;
    const float* src = p->w_in + (size_t)layer * DM * NIN + (size_t)k0 * NIN + 2048 + gi * 128;
#pragma unroll
    for (int i = 0; i < 4; ++i) { const int idx = tid + i * 512, k = idx >> 5, c4 = idx & 31; *(f32x4*)(wt + k * 128 + c4 * 4) = *(const f32x4*)(src + (size_t)k * NIN + c4 * 4); }
    const float* ps = p->pool_w + (size_t)(layer * 4 + gi) * 128 * 128;
#pragma unroll
    for (int i = 0; i < 8; ++i) { const int idx = tid + i * 512; *(f32x4*)(pl + idx * 4) = *(const f32x4*)(ps + idx * 4); }
    __syncthreads();
    const int d = tid & 127, kg = tid >> 7;
    float acc[16];
#pragma unroll
    for (int e = 0; e < 16; ++e) acc[e] = 0.f;
    for (int c = 0; c < 128; ++c) { const float w = pl[c * 128 + d];
#pragma unroll
        for (int e = 0; e < 16; ++e) acc[e] += wt[(kg * 16 + e) * 128 + c] * w; }
    const float sc = p->pool_scale[layer * 512 + gi * 128 + d];
    float v0[8], v1[8];
#pragma unroll
    for (int e = 0; e < 8; ++e) { v0[e] = acc[e] * sc; v1[e] = acc[8 + e] * sc; }
    bf16_t* dst = (bf16_t*)(p->ws + WS_WINT) + (size_t)layer * NIN * DM + (size_t)(2048 + gi * 128 + d) * DM + k0 + kg * 16;
    *(u32x4*)dst = pack8(v0); *(u32x4*)(dst + 8) = pack8(v1);
    __syncthreads();
}

__device__ void transpose_tile(const float* src, int srcld, int r0, int c0, bf16_t* dst, int dstld, int glu, unsigned char* smem) {
    const int tid = opaque_tid(); float* tile = (float*)smem;
    f32x4 v[8];
#pragma unroll
    for (int i = 0; i < 8; ++i) { const int idx = tid + i * 512, r = idx >> 6, c4 = idx & 63; v[i] = *(const f32x4*)(src + (size_t)(r0 + r) * srcld + c0 + c4 * 4); }
#pragma unroll
    for (int i = 0; i < 8; ++i) { const int idx = tid + i * 512, r = idx >> 6, c4 = idx & 63; *(f32x4*)(tile + r * 260 + ((c4 ^ (r >> 3)) << 2)) = v[i]; }
    __syncthreads();
#pragma unroll
    for (int i = 0; i < 4; ++i) { const int id = tid + i * 512, r8 = id & 7, c = id >> 3; float f[8];
#pragma unroll
        for (int e = 0; e < 8; ++e) f[e] = tile[(r8 * 8 + e) * 260 + ((((c >> 2) ^ r8) << 2) | (c & 3))];
        int drow = c0 + c;
        if (glu == 1) { drow = (drow < 512) ? ((drow >> 7) * 256 + (drow & 127)) : ((((drow - 512) >> 7) * 256) + 128 + ((drow - 512) & 127)); }
        else if (glu == 2 && drow >= 6144) {
            const int cc = drow - 6144, br = cc >> 11, ch = cc & 2047, pnl = ch >> 6, chl = ch & 63;
            drow = 6144 + 256 * pnl + 128 * (br >> 1) + 32 * (chl >> 4) + 8 * ((chl >> 2) & 3) + 4 * (br & 1) + (chl & 3); }
        *(u32x4*)(dst + (size_t)drow * dstld + r0 + r8 * 8) = pack8(f); }
    __syncthreads();
}

__device__ __forceinline__ void prep_layer_jobs(PP p, unsigned char* smem, int layer, int start, int stride, int jlo, int jhi) {
    for (int j = jlo + start; j < jhi; j += stride) {
        if (j < 48) job_mod(p, smem, layer * 48 + j);
        else if (j < 80) job_ssm(p, smem, layer * 32 + (j - 48));
        else if (j < 208) job_fold(p, smem, layer * 128 + (j - 80));
        else if (j < 2000) { const int rem = j - 208, rt = rem / 56, ct = rem % 56; if (ct == 8 || ct == 9) continue;
            transpose_tile(p->w_in + (size_t)layer * DM * NIN, NIN, rt * 64, ct * 256, (bf16_t*)(p->ws + WS_WINT) + (size_t)layer * NIN * DM, DM, 2, smem); }
        else if (j < 2256) { const int rem = j - 2000, rt = rem >> 3, ct = rem & 7;
            transpose_tile(p->w_br + (size_t)layer * DM * DM, DM, rt * 64, ct * 256, (bf16_t*)(p->ws + WS_WBRT) + (size_t)layer * DM * DM, DM, 0, smem); }
        else if (j < 2512) { const int rem = j - 2256, rt = rem >> 3, ct = rem & 7;
            transpose_tile(p->w_o + (size_t)layer * DM * DM, DM, rt * 64, ct * 256, (bf16_t*)(p->ws + WS_WOT) + (size_t)layer * DM * DM, DM, 0, smem); }
        else { const int rem = j - 2512, rt = rem >> 2, ct = rem & 3;
            transpose_tile(p->glu_w + (size_t)layer * 512 * 1024, 1024, rt * 64, ct * 256, (bf16_t*)(p->ws + WS_GLUT) + (size_t)layer * 1024 * 512, 512, 1, smem); }
    }
}

__device__ __forceinline__ float wave_sum(float v) {
#pragma unroll
    for (int o = 32; o >= 1; o >>= 1) v += __shfl_xor(v, o);
    return v;
}
__device__ __forceinline__ void norm_row(int layer, const float* xin, float* xst, const bf16_t* yrow, bf16_t* hrow, const float* sm, const float* smb, int lane) {
    f32x4 xv[8];
#pragma unroll
    for (int q = 0; q < 8; ++q) xv[q] = *(const f32x4*)(xin + (q * 64 + lane) * 4);
    if (layer >= 1) {
        f32x4 yv[8]; float ss = 0.f;
#pragma unroll
        for (int q = 0; q < 8; ++q) { const uint2 yw = *(const uint2*)(yrow + (q * 64 + lane) * 4); yv[q] = (f32x4){bflo(yw.x), bfhi(yw.x), bflo(yw.y), bfhi(yw.y)}; ss += yv[q][0] * yv[q][0] + yv[q][1] * yv[q][1] + yv[q][2] * yv[q][2] + yv[q][3] * yv[q][3]; }
        ss = wave_sum(ss); const float rs = rsqrtf(ss * (1.0f / DM) + 1e-6f);
#pragma unroll
        for (int q = 0; q < 8; ++q) { const int col = (q * 64 + lane) * 4; const f32x4 gt = *(const f32x4*)(smb + 2 * DM + col), gg = *(const f32x4*)(sm + DM + col);
#pragma unroll
            for (int e = 0; e < 4; ++e) xv[q][e] += gt[e] * (yv[q][e] * rs * gg[e]);
            *(f32x4*)(xst + col) = xv[q]; }
    }
    if (layer < 4) {
        float ss = 0.f;
#pragma unroll
        for (int q = 0; q < 8; ++q) ss += xv[q][0] * xv[q][0] + xv[q][1] * xv[q][1] + xv[q][2] * xv[q][2] + xv[q][3] * xv[q][3];
        ss = wave_sum(ss); const float rs = rsqrtf(ss * (1.0f / DM) + 1e-6f);
#pragma unroll
        for (int q = 0; q < 8; ++q) { const int col = (q * 64 + lane) * 4; const f32x4 sh = *(const f32x4*)(smb + col), sc = *(const f32x4*)(smb + DM + col), gg = *(const f32x4*)(sm + col);
            float h[4];
#pragma unroll
            for (int e = 0; e < 4; ++e) h[e] = (xv[q][e] * rs * gg[e]) * (1.0f + sc[e]) + sh[e];
            uint2 w; w.x = cvt_pk_bf16(h[0], h[1]); w.y = cvt_pk_bf16(h[2], h[3]);
            *(uint2*)(hrow + col) = w; }
    }
}
__device__ void norm_phase(PP p, int layer, unsigned char* smem) {
    const int tid = opaque_tid(), wid = tid >> 6, lane = tid & 63, blk = blockIdx.x;
    const float* mod = (const float*)(p->ws + WS_MOD);
    const bf16_t* Y = (const bf16_t*)(p->ws + WS_Y);
    bf16_t* H = (bf16_t*)(p->ws + WS_H);
    float* XC = (float*)(p->ws + WS_XC);
    float* sm = (float*)smem;
    const int b = (blk * 64) >> 12;
    for (int i = tid; i < DM / 4; i += 512) { const int c4 = i * 4;
        if (layer < 4) { *(f32x4*)(sm + c4) = *(const f32x4*)(p->g_pre + layer * DM + c4);
            *(f32x4*)(sm + 2 * DM + c4) = *(const f32x4*)(mod + (size_t)(layer * 5 + b) * 6144 + c4); *(f32x4*)(sm + 3 * DM + c4) = *(const f32x4*)(mod + (size_t)(layer * 5 + b) * 6144 + DM + c4);
            *(f32x4*)(sm + 5 * DM + c4) = *(const f32x4*)(mod + (size_t)(layer * 5 + 4) * 6144 + c4); *(f32x4*)(sm + 6 * DM + c4) = *(const f32x4*)(mod + (size_t)(layer * 5 + 4) * 6144 + DM + c4); }
        if (layer >= 1) { *(f32x4*)(sm + DM + c4) = *(const f32x4*)(p->g_post + (layer - 1) * DM + c4);
            *(f32x4*)(sm + 4 * DM + c4) = *(const f32x4*)(mod + (size_t)((layer - 1) * 5 + b) * 6144 + 2 * DM + c4); *(f32x4*)(sm + 7 * DM + c4) = *(const f32x4*)(mod + (size_t)((layer - 1) * 5 + 4) * 6144 + 2 * DM + c4); } }
    __syncthreads();
    for (int i = 0; i < 8; ++i) { const int row = blk * 64 + wid * 8 + i;
        float* xst = p->out + (size_t)row * DM; const float* xin = (layer <= 1) ? p->x + (size_t)row * DM : xst;
        norm_row(layer, xin, xst, Y + (size_t)row * DM, H + (size_t)row * DM, sm, sm + 2 * DM, lane); }
    if (layer < 4 && (wid & 1) == 0) { const int cr = blk * 4 + (wid >> 1), row = TLAT + cr;
        float* xst = XC + (size_t)cr * DM; const float* xin = (layer <= 1) ? p->ctx + (size_t)cr * DM : xst;
        norm_row(layer, xin, xst, Y + (size_t)row * DM, H + (size_t)row * DM, sm, sm + 5 * DM, lane); }
    __syncthreads();
}

__device__ void attn_phase(PP p, int layer) {
    const int tid = opaque_tid(), wid = tid >> 6, lane = tid & 63, qi = lane & 15, quad = lane >> 4;
    const bf16_t* PROJ = (const bf16_t*)(p->ws + WS_PROJ); const bf16_t* VT = (const bf16_t*)(p->ws + WS_VT); bf16_t* U = (bf16_t*)(p->ws + WS_U);
    const int ntask = 8192 + (layer < 3 ? 512 : 0);
    for (int task = blockIdx.x * 8 + wid; task < ntask; task += gridDim.x * 8) {
        int b, head, tq0, nband, r = 0, ct = 0, rs = 0, cs = 0;
        if (task < 8192) { ct = task & 3; r = (task >> 2) & 63; head = (task >> 8) & 7; b = task >> 11; tq0 = b * SEQ + r * 64 + ct * 16;
            rs = min(max(r - 4, 0), 56); cs = min(max(ct * 16 - 8, 0), 32); nband = 8; }
        else { const int t2 = task - 8192; head = (t2 >> 4) & 7; b = t2 >> 7; tq0 = TLAT + b * NCTX + (t2 & 15) * 16; nband = 0; }
        const bf16_t* qp = PROJ + (size_t)(tq0 + qi) * NIN + head * 64 + quad * 8;
        const bf16x8 qf0 = *(const bf16x8*)qp, qf1 = *(const bf16x8*)(qp + 32);
        f32x4 O[4];
#pragma unroll
        for (int dt = 0; dt < 4; ++dt) O[dt] = (f32x4){0.f, 0.f, 0.f, 0.f};
        float mrun = -1e30f, lrun = 0.f;
        const int qcol = ct * 16 + qi, start = min(max(qcol - 8, 0), 48);
        const float* rpbh = p->na_rpb + (size_t)(layer * 8 + head) * 15 * 31;
        const int kidx0 = (qi >> 2) * 8 + (qi & 3);
        const int nblk = nband + 8;
        for (int blk = 0; blk < nblk; blk += 2) {
            const bool band = blk < nband;
            bf16x8 kf[2][4], vf[2][4]; float sc[16];
#pragma unroll
            for (int h = 0; h < 2; ++h) {
                const int bb = blk + h;
                const int kb = band ? b * SEQ + (rs + bb) * 64 + cs : TLAT + b * NCTX + (bb - nband) * 32;
                const bf16_t* kp = PROJ + (size_t)(kb + kidx0) * NIN + 512 + head * 64 + quad * 8;
                kf[h][0] = *(const bf16x8*)kp; kf[h][1] = *(const bf16x8*)(kp + 32); kf[h][2] = *(const bf16x8*)(kp + 4 * NIN); kf[h][3] = *(const bf16x8*)(kp + 4 * NIN + 32);
                const bf16_t* vp = VT + (size_t)(head * 64 + qi) * T + kb + quad * 8;
#pragma unroll
                for (int dt = 0; dt < 4; ++dt) vf[h][dt] = *(const bf16x8*)(vp + (size_t)dt * 16 * T);
#pragma unroll
                for (int e = 0; e < 8; ++e) { float bias = 0.f;
                    if (band) { const int dcol = min(max(cs + quad * 8 + e - qcol + 15, 0), 30); bias = rpbh[(rs + bb - r + 7) * 31 + dcol]; }
                    sc[h * 8 + e] = bias; }
            }
#pragma unroll
            for (int h = 0; h < 2; ++h) {
                f32x4 s0 = (f32x4){0.f, 0.f, 0.f, 0.f}, s1 = (f32x4){0.f, 0.f, 0.f, 0.f};
                s0 = __builtin_amdgcn_mfma_f32_16x16x32_bf16(kf[h][0], qf0, s0, 0, 0, 0); s0 = __builtin_amdgcn_mfma_f32_16x16x32_bf16(kf[h][1], qf1, s0, 0, 0, 0);
                s1 = __builtin_amdgcn_mfma_f32_16x16x32_bf16(kf[h][2], qf0, s1, 0, 0, 0); s1 = __builtin_amdgcn_mfma_f32_16x16x32_bf16(kf[h][3], qf1, s1, 0, 0, 0);
#pragma unroll
                for (int e = 0; e < 8; ++e) { float sv = ((e < 4) ? s0[e & 3] : s1[e & 3]) + sc[h * 8 + e];
                    if (band) { const int kcol = cs + quad * 8 + e; const bool ok = (kcol >= start) && (kcol < start + 16); sv = ok ? sv : -1e30f; }
                    sc[h * 8 + e] = sv; }
            }
            float mx = sc[0];
#pragma unroll
            for (int e = 1; e < 16; ++e) mx = fmaxf(mx, sc[e]);
            mx = fmaxf(mx, __shfl_xor(mx, 16)); mx = fmaxf(mx, __shfl_xor(mx, 32));
            const float mnew = fmaxf(mrun, mx), alpha = __expf(mrun - mnew);
            float ps = 0.f, pv[16];
#pragma unroll
            for (int e = 0; e < 16; ++e) { pv[e] = __expf(sc[e] - mnew); ps += pv[e]; }
            lrun = lrun * alpha + ps; mrun = mnew;
#pragma unroll
            for (int jj = 0; jj < 4; ++jj) { const float aj = __shfl(alpha, quad * 4 + jj);
#pragma unroll
                for (int dt = 0; dt < 4; ++dt) O[dt][jj] *= aj; }
#pragma unroll
            for (int h = 0; h < 2; ++h) { float ph[8];
#pragma unroll
                for (int e = 0; e < 8; ++e) ph[e] = pv[h * 8 + e];
                const u32x4 pw4 = pack8(ph); bf16x8 pf; __builtin_memcpy(&pf, &pw4, 16);
#pragma unroll
                for (int dt = 0; dt < 4; ++dt) O[dt] = __builtin_amdgcn_mfma_f32_16x16x32_bf16(pf, vf[h][dt], O[dt], 0, 0, 0); }
        }
        float ltot = lrun + __shfl_xor(lrun, 16); ltot += __shfl_xor(ltot, 32);
        const float inv = 1.0f / ltot;
#pragma unroll
        for (int jj = 0; jj < 4; ++jj) { const float ij = __shfl(inv, quad * 4 + jj); const int tok = tq0 + quad * 4 + jj;
#pragma unroll
            for (int dt = 0; dt < 4; ++dt) { const int d = dt * 16 + qi; const float z = bf2f(PROJ[(size_t)tok * NIN + 1536 + head * 64 + d]);
                U[(size_t)tok * DM + head * 64 + d] = f2bf(O[dt][jj] * ij * z); } }
    }
}

__device__ void elem_phase(PP p, int layer) {
    const bf16_t* __restrict__ PROJ = (const bf16_t*)(p->ws + WS_PROJ); bf16_t* __restrict__ U = (bf16_t*)(p->ws + WS_U);
    const int nitems = (TLAT / 16) * 128;
    for (int it = blockIdx.x * 512 + opaque_tid(); it < nitems; it += gridDim.x * 512) {
        const int chunk = it >> 7, cgp = it & 127, tok0 = chunk * 16;
        int l0, L; if (tok0 < TLAT) { l0 = tok0 & (SEQ - 1); L = SEQ; } else { l0 = (tok0 - TLAT) & (NCTX - 1); L = NCTX; }
        const int seq0 = tok0 - l0;
        if (cgp < 64) {
            const int c0 = cgp * 8, gi = c0 >> 7, w = 2 << gi, hw = w >> 1;
            const bf16_t* ub = PROJ + (size_t)seq0 * NIN + 2048 + c0;
            int lo = max(l0 - hw, 0), hi = min(l0 + w - hw, L);
            float s[8];
#pragma unroll
            for (int e = 0; e < 8; ++e) s[e] = 0.f;
            for (int tt = lo; tt < hi; ++tt) { float f[8]; unpack8(*(const u32x4*)(ub + (size_t)tt * NIN), f);
#pragma unroll
                for (int e = 0; e < 8; ++e) s[e] += f[e]; }
#pragma unroll 4
            for (int i = 0; i < 16; ++i) { const int l = l0 + i;
                float self[8], z[8]; unpack8(*(const u32x4*)(ub + (size_t)l * NIN), self); unpack8(*(const u32x4*)(ub + (size_t)l * NIN + 512), z);
                const float ic = 1.0f / (float)(hi - lo); float o[8];
#pragma unroll
                for (int e = 0; e < 8; ++e) o[e] = (s[e] * ic - self[e]) * z[e];
                *(u32x4*)(U + (size_t)(seq0 + l) * DM + 512 + c0) = pack8(o);
                const int nhi = min(l + 1 + w - hw, L), nlo = max(l + 1 - hw, 0);
                if (nhi > hi) { float f[8]; unpack8(*(const u32x4*)(ub + (size_t)hi * NIN), f);
#pragma unroll
                    for (int e = 0; e < 8; ++e) s[e] += f[e];
                    hi = nhi; }
                if (nlo > lo) { float f[8]; unpack8(*(const u32x4*)(ub + (size_t)lo * NIN), f);
#pragma unroll
                    for (int e = 0; e < 8; ++e) s[e] -= f[e];
                    lo = nlo; } }
        } else {
            const int c0 = (cgp - 64) * 8; const bf16_t* base = PROJ + (size_t)seq0 * NIN + c0;
            const float* cw = p->conv_w + (size_t)layer * 3 * 512 + c0;
            float w0[8], w1[8], w2[8];
#pragma unroll
            for (int e = 0; e < 8; ++e) { w0[e] = cw[e]; w1[e] = cw[512 + e]; w2[e] = cw[1024 + e]; }
            float xm[8], x0[8], xp[8];
            if (l0 > 0) { float a[8], c[8]; unpack8(*(const u32x4*)(base + (size_t)(l0 - 1) * NIN + 3072), a); unpack8(*(const u32x4*)(base + (size_t)(l0 - 1) * NIN + 4096), c);
#pragma unroll
                for (int e = 0; e < 8; ++e) xm[e] = a[e] * c[e]; }
            else {
#pragma unroll
                for (int e = 0; e < 8; ++e) xm[e] = 0.f; }
            { float a[8], c[8]; unpack8(*(const u32x4*)(base + (size_t)l0 * NIN + 3072), a); unpack8(*(const u32x4*)(base + (size_t)l0 * NIN + 4096), c);
#pragma unroll
                for (int e = 0; e < 8; ++e) x0[e] = a[e] * c[e]; }
#pragma unroll 4
            for (int i = 0; i < 16; ++i) { const int l = l0 + i;
                if (l < L - 1) { float a[8], c[8]; unpack8(*(const u32x4*)(base + (size_t)(l + 1) * NIN + 3072), a); unpack8(*(const u32x4*)(base + (size_t)(l + 1) * NIN + 4096), c);
#pragma unroll
                    for (int e = 0; e < 8; ++e) xp[e] = a[e] * c[e]; }
                else {
#pragma unroll
                    for (int e = 0; e < 8; ++e) xp[e] = 0.f; }
                float gb[8], z[8]; unpack8(*(const u32x4*)(base + (size_t)l * NIN + 3584), gb); unpack8(*(const u32x4*)(base + (size_t)l * NIN + 4608), z);
                float o[8];
#pragma unroll
                for (int e = 0; e < 8; ++e) o[e] = gb[e] * (w0[e] * xm[e] + w1[e] * x0[e] + w2[e] * xp[e]) * z[e];
                *(u32x4*)(U + (size_t)(seq0 + l) * DM + 1024 + c0) = pack8(o);
#pragma unroll
                for (int e = 0; e < 8; ++e) { xm[e] = x0[e]; x0[e] = xp[e]; } }
        }
    }
}

__device__ void elem_ctx_tokens(PP p, int layer) {
    const bf16_t* __restrict__ PROJ = (const bf16_t*)(p->ws + WS_PROJ); bf16_t* __restrict__ U = (bf16_t*)(p->ws + WS_U);
    const int nitems = TCTX * 128;
#pragma unroll 2
    for (int it = blockIdx.x * 512 + opaque_tid(); it < nitems; it += gridDim.x * 512) {
        const int tok = TLAT + (it >> 7), cgp = it & 127;
        int l, L; if (tok < TLAT) { l = tok & (SEQ - 1); L = SEQ; } else { l = (tok - TLAT) & (NCTX - 1); L = NCTX; }
        const int seq0 = tok - l;
        if (cgp < 64) {
            const int c0 = cgp * 8, gi = c0 >> 7, w = 2 << gi, lo = max(l - (w >> 1), 0), hi = min(l + w - (w >> 1), L);
            float s[8];
#pragma unroll
            for (int e = 0; e < 8; ++e) s[e] = 0.f;
            for (int tt = lo; tt < hi; ++tt) { float f[8]; unpack8(*(const u32x4*)(PROJ + (size_t)(seq0 + tt) * NIN + 2048 + c0), f);
#pragma unroll
                for (int e = 0; e < 8; ++e) s[e] += f[e]; }
            float self[8], z[8]; unpack8(*(const u32x4*)(PROJ + (size_t)tok * NIN + 2048 + c0), self); unpack8(*(const u32x4*)(PROJ + (size_t)tok * NIN + 2560 + c0), z);
            const float ic = 1.0f / (float)(hi - lo); float o[8];
#pragma unroll
            for (int e = 0; e < 8; ++e) o[e] = (s[e] * ic - self[e]) * z[e];
            *(u32x4*)(U + (size_t)tok * DM + 512 + c0) = pack8(o);
        } else {
            const int c0 = (cgp - 64) * 8; const bf16_t* base = PROJ + (size_t)tok * NIN + c0;
            float xm[8], x0[8], xp[8], cm[8], c0v[8], cp[8], gb[8], z[8];
            unpack8(*(const u32x4*)(base + 3072), x0); unpack8(*(const u32x4*)(base + 4096), c0v); unpack8(*(const u32x4*)(base + 3584), gb); unpack8(*(const u32x4*)(base + 4608), z);
            if (l > 0) { unpack8(*(const u32x4*)(base - NIN + 3072), xm); unpack8(*(const u32x4*)(base - NIN + 4096), cm); }
            else {
#pragma unroll
                for (int e = 0; e < 8; ++e) { xm[e] = 0.f; cm[e] = 0.f; } }
            if (l < L - 1) { unpack8(*(const u32x4*)(base + NIN + 3072), xp); unpack8(*(const u32x4*)(base + NIN + 4096), cp); }
            else {
#pragma unroll
                for (int e = 0; e < 8; ++e) { xp[e] = 0.f; cp[e] = 0.f; } }
            const float* cw = p->conv_w + (size_t)layer * 3 * 512 + c0; float o[8];
#pragma unroll
            for (int e = 0; e < 8; ++e) o[e] = gb[e] * (cw[e] * (xm[e] * cm[e]) + cw[512 + e] * (x0[e] * c0v[e]) + cw[1024 + e] * (xp[e] * cp[e])) * z[e];
            *(u32x4*)(U + (size_t)tok * DM + 1024 + c0) = pack8(o);
        }
    }
}

__device__ void carry_phase(PP p, int layer) {
    const int id = (gridDim.x - 1 - blockIdx.x) * 512 + opaque_tid(); if (id >= 16384) return;
    const int pp = id & 63, g = (id >> 6) & 31, dir = (id >> 11) & 1, b = id >> 12;
    const float* a16 = (const float*)(p->ws + WS_A16) + (size_t)(((layer * 2 + dir) * 32 + g) * 64 + pp) * 2;
    const float ar = a16[0], ai = a16[1];
    const float* E = (const float*)(p->ws + WS_E) + (size_t)g * XROWS * 256 + dir * 128 + pp;
    bf16_t* X = (bf16_t*)(p->ws + WS_X) + (size_t)g * XROWS * 512 + 256 + dir * 128 + pp;
    float sr = 0.f, si = 0.f;
    for (int s0 = 0; s0 < 272; s0 += 8) {
        float er[8], ei[8]; int nn[8];
#pragma unroll
        for (int q = 0; q < 8; ++q) { const int s = s0 + q; int n;
            if (s < 16) n = 1024 + b * 16 + (dir ? 15 - s : s); else n = b * 256 + (dir ? 255 - (s - 16) : (s - 16));
            nn[q] = n; er[q] = E[(size_t)n * 256]; ei[q] = E[(size_t)n * 256 + 64]; }
#pragma unroll
        for (int q = 0; q < 8; ++q) { X[(size_t)nn[q] * 512] = f2bf(sr); X[(size_t)nn[q] * 512 + 64] = f2bf(si);
            const float nr = ar * sr - ai * si + er[q], ni = ar * si + ai * sr + ei[q]; sr = nr; si = ni; }
    }
}

#define XB_TMO      128
#define XB_XCNT(j)  (256  + 64 * (j))
#define XB_XSUB(j)  (1280 + 64 * (j))
#define XB_XGEN(j)  (2304 + 64 * (j))
#define XB_TOP      3328
#define XB_TOPGEN   3392
#define XCD_BAR_WORDS 3456
#define XB_SPIN_CAP (1u << 18)
__device__ __forceinline__ unsigned xb_ld(unsigned* p)              { return __hip_atomic_load(p, __ATOMIC_RELAXED, __HIP_MEMORY_SCOPE_AGENT); }
__device__ __forceinline__ unsigned xb_add(unsigned* p, unsigned v) { return __hip_atomic_fetch_add(p, v, __ATOMIC_RELAXED, __HIP_MEMORY_SCOPE_AGENT); }
__device__ __forceinline__ unsigned xb_xcc_id() { return (unsigned)__builtin_amdgcn_s_getreg((3 << 11) | 20) & 0xFu; }
#define XB_SPIN(cond, bar) do { unsigned _sp = 0; while (cond) { __builtin_amdgcn_s_sleep(1); \
    if ((++_sp & 255u) == 0u) { if (xb_ld(&(bar)[XB_TMO])) break; if (_sp > XB_SPIN_CAP) { atomicAdd(&(bar)[XB_TMO], 1u); break; } } } } while (0)
__device__ __forceinline__ void xcd_barrier_complete(unsigned* bar, unsigned x, unsigned& nloc, unsigned& nx) {
    const unsigned G = gridDim.x;
    unsigned sum, cnt, mine, sp = 0u;
    for (;;) {
        sum = 0u; cnt = 0u; mine = 0u;
#pragma unroll
        for (unsigned j = 0; j < 16; ++j) { const unsigned c = xb_ld(&bar[XB_XCNT(j)]); sum += c; cnt += (c > 0u) ? 1u : 0u; mine = (j == x) ? c : mine; }
        if (sum == G) break;
        __builtin_amdgcn_s_sleep(1);
        if ((++sp & 255u) == 0u) { if (xb_ld(&bar[XB_TMO])) break; if (sp > XB_SPIN_CAP) { atomicAdd(&bar[XB_TMO], 1u); break; } }
    }
    nloc = mine > 0u ? mine : 1u; nx = cnt > 0u ? cnt : 1u;
}
__device__ __forceinline__ void xcd_barrier(unsigned* bar, volatile LAS unsigned* st) {
    asm volatile("s_waitcnt vmcnt(0)" ::: "memory");
    __syncthreads();
    if (threadIdx.x == 0) {
        __builtin_amdgcn_s_waitcnt(0);
        const unsigned x = xb_xcc_id();
        unsigned nloc = st[0], nx = st[1];
        if (nloc == 0u) { xcd_barrier_complete(bar, x, nloc, nx); st[0] = nloc; st[1] = nx; }
        const unsigned old = xb_add(&bar[XB_XSUB(x)], 1u);
        const unsigned gen = old / nloc;
        if (old + 1u == (gen + 1u) * nloc) {
            __builtin_amdgcn_fence(__ATOMIC_RELEASE, "agent");
            asm volatile("s_waitcnt vmcnt(0)" ::: "memory");
            const unsigned og = xb_add(&bar[XB_TOP], 1u);
            const unsigned tg = og / nx;
            if (og + 1u == (tg + 1u) * nx) xb_add(&bar[XB_TOPGEN], 1u);
            else XB_SPIN(xb_ld(&bar[XB_TOPGEN]) == tg, bar);
            __builtin_amdgcn_fence(__ATOMIC_ACQUIRE, "agent");
            xb_add(&bar[XB_XGEN(x)], 1u);
            asm volatile("s_waitcnt vmcnt(0)" ::: "memory");
        } else {
            XB_SPIN(xb_ld(&bar[XB_XGEN(x)]) == gen, bar);
            __builtin_amdgcn_fence(__ATOMIC_ACQUIRE, "agent");
            asm volatile("s_waitcnt vmcnt(0)" ::: "memory");
        }
    }
    __syncthreads();
}

template <int PMASK> __device__ __forceinline__ void run_phase(PP p, int ph, unsigned char* smem) {
    LAS unsigned char* lds = (LAS unsigned char*)smem;
    const int G = gridDim.x, c = blockIdx.x;
    if (ph == 0) { if constexpr ((PMASK >> 8) & 1) prep_layer_jobs(p, smem, 0, blockIdx.x, gridDim.x, 0, 2544); return; }
    if (ph == 33) { if constexpr ((PMASK >> 0) & 1) norm_phase(p, 4, smem); return; }
    const int layer = (ph - 1) >> 3, sub = (ph - 1) & 7;
    const char* ws = (const char*)p->ws;
    switch (sub) {
    case 0: if constexpr ((PMASK >> 0) & 1) norm_phase(p, layer, smem); break;
    case 1: if constexpr ((PMASK >> 1) & 1) { OrderInproj S{ws + WS_WINT + (size_t)layer * NIN * DM * 2, ws + WS_H, G, c};
        EpiInproj Ep{(bf16_t*)(p->ws + WS_PROJ), (bf16_t*)(p->ws + WS_VT), (bf16_t*)(p->ws + WS_X), p->b_gate + layer * 8192, (bf16_t*)(p->ws + WS_R)};
        pg8::gemm_phase(lds, pg8::Gemm{DM, DM, DM}, S, Ep); } break;
    case 2: if constexpr ((PMASK >> 2) & 1) { OrderGroup S{ws + WS_X, ws + WS_WG + (size_t)layer * 32 * 256 * 256 * 2, 256, G, c};
        EpiE Ep{(float*)(p->ws + WS_E)};
        pg8::gemm_phase(lds, pg8::Gemm{512, 256, 256}, S, Ep); } break;
    case 3: if constexpr ((PMASK >> 3) & 1) { carry_phase(p, layer); attn_phase(p, layer); elem_phase(p, layer); if (layer < 3) elem_ctx_tokens(p, layer);
#ifdef DUP3
        if (DUP3 & 1) carry_phase(p, layer);
        if (DUP3 & 2) attn_phase(p, layer);
        if (DUP3 & 4) elem_phase(p, layer);
#endif
        } break;
    case 4: if constexpr ((PMASK >> 4) & 1) { OrderGroup S{ws + WS_X, ws + WS_MG + (size_t)layer * 32 * 256 * 512 * 2, 512, G, c};
        EpiY Ep{(bf16_t*)(p->ws + WS_G)};
        pg8::gemm_phase(lds, pg8::Gemm{512, 512, 512}, S, Ep); } break;
    case 5: if constexpr ((PMASK >> 5) & 1) { OrderSimple S{ws + WS_G, ws + WS_GLUT + (size_t)layer * 1024 * 512 * 2, layer == 3 ? 64 : 68, 4, 512, 512, G, c};
        EpiGlu Ep{(const bf16_t*)(p->ws + WS_PROJ), (bf16_t*)(p->ws + WS_U)};
        pg8::gemm_phase(lds, pg8::Gemm{512, 512, 512}, S, Ep); } break;
    case 6: if constexpr ((PMASK >> 6) & 1) { OrderSimple S{ws + WS_U, ws + WS_WBRT + (size_t)layer * DM * DM * 2, layer == 3 ? 64 : 68, 8, DM, DM, G, c};
        EpiBranch Ep{(const bf16_t*)(p->ws + WS_R), (bf16_t*)(p->ws + WS_MRG)};
        pg8::gemm_phase(lds, pg8::Gemm{DM, DM, DM}, S, Ep);
        if (layer < 3 && c >= 32) { __syncthreads(); prep_layer_jobs(p, smem, layer + 1, c - 32, G - 32, 0, 2544); } } break;
    case 7: if constexpr ((PMASK >> 7) & 1) { OrderSimple S{ws + WS_MRG, ws + WS_WOT + (size_t)layer * DM * DM * 2, layer == 3 ? 64 : 68, 8, DM, DM, G, c};
        EpiWo Ep{(bf16_t*)(p->ws + WS_Y)};
        pg8::gemm_phase(lds, pg8::Gemm{DM, DM, DM}, S, Ep);
        if (layer < 3 && c >= 32) { __syncthreads(); prep_layer_jobs(p, smem, layer + 1, c - 32, G - 32, 2544, 2544); } } break;
    }
}

template <int PMASK> __global__ void __launch_bounds__(512, 2) hybrid_mega(Params p_byval) {
    extern __shared__ __attribute__((aligned(16))) unsigned char smem[];
    cg::grid_group grid = cg::this_grid();
    PP p0 = (PP)__builtin_amdgcn_kernarg_segment_ptr();
    const int lo = p0->ph_lo, hi = p0->ph_hi;
    {
        volatile LAS unsigned* st = (volatile LAS unsigned*)((LAS unsigned char*)smem + 131072);
        if (threadIdx.x == 0) { st[0] = 0u; st[1] = 0u; (void)xb_add(&((unsigned*)(p0->ws + WS_BAR))[XB_XCNT(xb_xcc_id())], 1u); }
        __syncthreads();
    }
    for (int ph = lo; ph < hi; ++ph) {
        if (ph == lo + 1) grid.sync();
        else if (ph > lo) { PP pb = p0; asm volatile("" : "+s"(pb)); xcd_barrier((unsigned*)(pb->ws + WS_BAR), (volatile LAS unsigned*)((LAS unsigned char*)smem + 131072)); }
        PP p = p0; asm volatile("" : "+s"(p));
        run_phase<PMASK>(p, ph, smem);
#ifdef DUP_SUB
        if (ph >= 1 && ph <= 32 && ((ph - 1) & 7) == DUP_SUB) { grid.sync(); PP p2 = p0; asm volatile("" : "+s"(p2)); run_phase<PMASK>(p2, ph, smem); }
#endif
#ifdef DUP_NORM0
        if (ph == 1) { grid.sync(); PP p2 = p0; asm volatile("" : "+s"(p2)); run_phase<PMASK>(p2, ph, smem); }
#endif
#ifdef DUP_PREP
        if (ph == 0) { grid.sync(); PP p2 = p0; asm volatile("" : "+s"(p2)); run_phase<PMASK>(p2, ph, smem); }
#endif
    }
}

extern "C" void kernel_launch(void* const* d_in, const int* in_sizes, int n_in, void* d_out, int out_size, void* d_ws, size_t ws_size, hipStream_t stream) {
    static int grid = 0;
    if (grid == 0) {
        if (n_in != 25 || ws_size < WS_END) { fprintf(stderr, "kernel_launch: unexpected n_in %d or ws_size %zu (< %zu)\n", n_in, ws_size, (size_t)WS_END); grid = -1; return; }
        bool okattr = true;
#if MULTI_LAUNCH
#define SETATTR(M) okattr = okattr && (hipFuncSetAttribute((const void*)hybrid_mega<M>, hipFuncAttributeMaxDynamicSharedMemorySize, LDS_BYTES) == hipSuccess)
        SETATTR(0x001); SETATTR(0x002); SETATTR(0x004); SETATTR(0x008); SETATTR(0x010); SETATTR(0x020); SETATTR(0x040); SETATTR(0x080); SETATTR(0x100);
#else
        okattr = hipFuncSetAttribute((const void*)hybrid_mega<0xFFFF>, hipFuncAttributeMaxDynamicSharedMemorySize, LDS_BYTES) == hipSuccess;
#endif
        if (!okattr) { fprintf(stderr, "kernel_launch: hipFuncSetAttribute failed\n"); grid = -1; return; }
        int dev = 0, cus = 0, per_cu = 0;
        (void)hipGetDevice(&dev); (void)hipDeviceGetAttribute(&cus, hipDeviceAttributeMultiprocessorCount, dev);
#if !MULTI_LAUNCH
        (void)hipOccupancyMaxActiveBlocksPerMultiprocessor(&per_cu, (const void*)hybrid_mega<0xFFFF>, 512, LDS_BYTES);
        if (per_cu < 1) { fprintf(stderr, "kernel_launch: occupancy query says %d blocks per CU\n", per_cu); per_cu = 1; }
#endif
        (void)hipGetLastError();
        if (cus < 256) { fprintf(stderr, "kernel_launch: built for a 256-CU device (got %d CUs)\n", cus); grid = -1; return; }
        grid = 256;
    }
    if (grid < 0) return;
    Params p{};
    const float** pp = (const float**)&p;
    for (int i = 0; i < 25; ++i) pp[i] = (const float*)d_in[i];
    p.out = (float*)d_out; p.ws = (unsigned char*)d_ws;
#if MULTI_LAUNCH
    for (int ph = 0; ph < 34; ++ph) { p.ph_lo = ph; p.ph_hi = ph + 1;
        const int sub = (ph == 0) ? 8 : (ph == 33 ? 0 : ((ph - 1) & 7));
        switch (sub) {
#define LCH(K) case K: hipLaunchKernelGGL(hybrid_mega<(1 << K)>, dim3(grid), dim3(512), LDS_BYTES, stream, p); break
        LCH(0); LCH(1); LCH(2); LCH(3); LCH(4); LCH(5); LCH(6); LCH(7); LCH(8);
        } }
#else
    p.ph_lo = 0; p.ph_hi = 34;
    (void)hipMemsetAsync((unsigned char*)d_ws + WS_BAR, 0, 16384, stream);
    void* args[] = {&p};
    hipError_t e = hipLaunchCooperativeKernel((const void*)hybrid_mega<0xFFFF>, dim3(grid), dim3(512), args, LDS_BYTES, stream);
    if (e != hipSuccess) fprintf(stderr, "cooperative launch failed: %s (grid %d)\n", hipGetErrorString(e), grid);
#endif
}
```

```cpp
#include <hip/hip_runtime.h>
#include <hip/hip_cooperative_groups.h>
#include <cstdio>
namespace cg = cooperative_groups;

#ifndef MULTI_LAUNCH
#define MULTI_LAUNCH 0
#endif

#define LAS __attribute__((address_space(3)))
typedef unsigned short bf16_t;
typedef short bf16x8 __attribute__((ext_vector_type(8)));
typedef float f32x4 __attribute__((ext_vector_type(4)));
typedef unsigned u32x4 __attribute__((ext_vector_type(4)));

constexpr int DM = 2048, NBATCH = 4, SEQ = 4096, NCTX = 256;
constexpr int TLAT = NBATCH * SEQ, TCTX = NBATCH * NCTX, T = TLAT + TCTX;
constexpr int NIN = 14336;
constexpr int NCHUNK = T / 16;
constexpr int XROWS = 1280;
constexpr int LDS_BYTES = 131072 + 16;

constexpr size_t WS_WINT = 0;
constexpr size_t WS_WBRT = WS_WINT + (size_t)4 * NIN * DM * 2;
constexpr size_t WS_WOT  = WS_WBRT + (size_t)4 * DM * DM * 2;
constexpr size_t WS_GLUT = WS_WOT + (size_t)4 * DM * DM * 2;
constexpr size_t WS_MG   = WS_GLUT + (size_t)4 * 1024 * 512 * 2;
constexpr size_t WS_WG   = WS_MG + (size_t)4 * 32 * 256 * 512 * 2;
constexpr size_t WS_A16  = WS_WG + (size_t)4 * 32 * 256 * 256 * 2;
constexpr size_t WS_MOD  = WS_A16 + (size_t)4 * 2 * 32 * 64 * 2 * 4;
constexpr size_t WS_H    = WS_MOD + (size_t)4 * 5 * 6144 * 4;
constexpr size_t WS_PROJ = WS_H + (size_t)T * DM * 2;
constexpr size_t WS_VT   = WS_PROJ + (size_t)T * NIN * 2;
constexpr size_t WS_X    = WS_VT + (size_t)512 * T * 2;
constexpr size_t WS_E    = WS_X + (size_t)32 * XROWS * 512 * 2;
constexpr size_t WS_G    = WS_E + (size_t)32 * XROWS * 256 * 4;
constexpr size_t WS_U    = WS_G + (size_t)T * 512 * 2;
constexpr size_t WS_MRG  = WS_U + (size_t)T * DM * 2;
constexpr size_t WS_Y    = WS_MRG + (size_t)T * DM * 2;
constexpr size_t WS_XC   = WS_Y + (size_t)T * DM * 4;
constexpr size_t WS_BAR  = WS_XC + (size_t)TCTX * DM * 4;
constexpr size_t WS_R    = WS_BAR + 16384;
constexpr size_t WS_END  = WS_R + (size_t)4 * T * DM * 2;

struct Params {
    const float *x, *c, *ctx, *c_ctx, *w_mod, *b_mod, *g_pre, *g_post, *w_in, *b_gate, *na_rpb, *pool_w, *pool_scale, *conv_w,
        *a_re, *a_im, *log_dt, *b_re, *b_im, *c_re, *c_im, *ssm_d, *glu_w, *w_br, *w_o;
    float* out; unsigned char* ws; int ph_lo, ph_hi;
};

typedef const __attribute__((address_space(4))) Params* PP;

typedef float f32x2_t __attribute__((ext_vector_type(2)));
typedef __bf16 bf16x2_t __attribute__((ext_vector_type(2)));
__device__ __forceinline__ unsigned cvt_pk_bf16(float lo, float hi) { const f32x2_t f = {lo, hi}; const bf16x2_t b = __builtin_convertvector(f, bf16x2_t); unsigned r; __builtin_memcpy(&r, &b, 4); return r; }
__device__ __forceinline__ bf16_t f2bf(float f) { unsigned u = __float_as_uint(f); u += 0x7FFFu + ((u >> 16) & 1u); return (bf16_t)(u >> 16); }
__device__ __forceinline__ float bf2f(bf16_t b) { return __uint_as_float(((unsigned)b) << 16); }
__device__ __forceinline__ float bflo(unsigned w) { return __uint_as_float(w << 16); }
__device__ __forceinline__ float bfhi(unsigned w) { return __uint_as_float(w & 0xFFFF0000u); }
__device__ __forceinline__ float sigmoidf_(float x) { return __builtin_amdgcn_rcpf(1.0f + __builtin_amdgcn_exp2f(-1.4426950408889634f * x)); }
__device__ __forceinline__ float siluf_(float x) { return x * sigmoidf_(x); }
__device__ __forceinline__ float gelu_tanh(float y) { const float u = 0.7978845608028654f * (y + 0.044715f * y * y * y); return y * sigmoidf_(2.0f * u); }
__device__ __forceinline__ void unpack8(const u32x4 w, float (&f)[8]) { f[0] = bflo(w.x); f[1] = bfhi(w.x); f[2] = bflo(w.y); f[3] = bfhi(w.y); f[4] = bflo(w.z); f[5] = bfhi(w.z); f[6] = bflo(w.w); f[7] = bfhi(w.w); }
__device__ __forceinline__ u32x4 pack8(const float (&f)[8]) { u32x4 w; w.x = cvt_pk_bf16(f[0], f[1]); w.y = cvt_pk_bf16(f[2], f[3]); w.z = cvt_pk_bf16(f[4], f[5]); w.w = cvt_pk_bf16(f[6], f[7]); return w; }

__device__ __forceinline__ int opaque_tid() { int t = threadIdx.x; asm volatile("" : "+v"(t)); return t; }

namespace pg8 {
constexpr int BM = 256, BK = 64, HALF = 128, HTB = HALF * BK * 2, STAGE_BYTES = 8 * HTB, NXCD = 8, WGM = 4;
__device__ __forceinline__ int lds_byte(int r, int c) { const int st = (r >> 4) * 2 + (c >> 5), rr = r & 15, cc = c & 31, ob = rr * 64 + cc * 2; return st * 1024 + (ob ^ (((ob >> 9) & 1) << 5)); }
__device__ __forceinline__ void stage_rc(int b, int& R, int& C) { const int st = b / 1024, sb = b % 1024, swz = sb ^ (((sb >> 9) & 1) << 5); R = (st >> 1) * 16 + swz / 64; C = (st & 1) * 32 + (swz % 64) / 2; }
__device__ __forceinline__ int perm32(int rho) { const int n = rho >> 4, i = rho & 15; return 8 * (i >> 2) + 4 * n + (i & 3); }

struct Unit { const char* a; const char* b; int pm, pn, kind; };
struct Gemm { int lda, ldb, K; };

__device__ __forceinline__ void swz_tile(int L, int nM, int nN, int& pm, int& pn) {
    const int nwg = nM * nN; int wgid = L;
    { const int q = nwg / NXCD, r = nwg % NXCD, xcd = wgid % NXCD, off = wgid / NXCD; wgid = (xcd < r ? xcd * (q + 1) : r * (q + 1) + (xcd - r) * q) + off; }
    const int nig = WGM * nN, gid = wgid / nig, fm = gid * WGM, gsz = (nM - fm) < WGM ? (nM - fm) : WGM;
    pm = fm + ((wgid % nig) % gsz); pn = (wgid % nig) / gsz;
}

template <class Epi, class Sched>
__device__ __forceinline__ void gemm_phase(LAS unsigned char* lds, const Gemm g, const Sched& S, const Epi& E) {
    const int tid = opaque_tid(), wid = __builtin_amdgcn_readfirstlane(tid >> 6), lane = tid & 63, wr = wid >> 2, wc = wid & 3, fr = lane & 15, fq = lane >> 4;
    int K = g.K; asm volatile("" : "+s"(K)); const int nt = K / BK;
    unsigned voffA[2], voffB[2];
#pragma unroll
    for (int i = 0; i < 2; ++i) { int R, C; stage_rc(tid * 16 + i * 8192, R, C); const int Rb = Epi::PERM ? ((R & ~31) + perm32(R & 31)) : R;
        voffA[i] = (unsigned)(R * g.lda + C) * 2u; voffB[i] = (unsigned)(Rb * g.ldb + C) * 2u; }
    const size_t kstep = (size_t)(BK * 2);
    const size_t hstepA = (size_t)HALF * g.lda * 2, hstepB = (size_t)HALF * g.ldb * 2;
    const unsigned ldsw = (unsigned)wid * 1024u;
    const int aoff = lds_byte(wr * 64 + fr, fq * 8), boff = lds_byte(wc * 32 + fr, fq * 8);
#define PG8_SA(b, h) (((b) * 2 + (h)) * HTB)
#define PG8_SB(b, h) ((4 + (b) * 2 + (h)) * HTB)
#define PG8_STAGE(bufoff, gbase, voff) do { _Pragma("unroll") for (int _i = 0; _i < 2; ++_i) \
        __builtin_amdgcn_global_load_lds((const unsigned*)((const char*)(gbase) + (voff)[_i]), (LAS unsigned*)(lds + (bufoff) + ldsw + _i * 8192), 16, 0, 0); } while (0)
#define PG8_LDA(dst, b, h) do { _Pragma("unroll") for (int m = 0; m < 4; ++m) _Pragma("unroll") for (int k = 0; k < 2; ++k) dst[m][k] = *(const LAS bf16x8*)(lds + PG8_SA(b, h) + aoff + m * 2048 + k * 1024); } while (0)
#define PG8_LDB(dst, b, h) do { _Pragma("unroll") for (int n = 0; n < 2; ++n) _Pragma("unroll") for (int k = 0; k < 2; ++k) dst[n][k] = *(const LAS bf16x8*)(lds + PG8_SB(b, h) + boff + n * 2048 + k * 1024); } while (0)
#define PG8_MMA(ai, bj, At, Bt) do { __builtin_amdgcn_s_setprio(1); _Pragma("unroll") for (int m = 0; m < 4; ++m) _Pragma("unroll") for (int n = 0; n < 2; ++n) _Pragma("unroll") for (int k = 0; k < 2; ++k) \
        acc[ai][bj][m][n] = __builtin_amdgcn_mfma_f32_16x16x32_bf16(Bt[n][k], At[m][k], acc[ai][bj][m][n], 0, 0, 0); __builtin_amdgcn_s_setprio(0); } while (0)
#ifdef SAFE_WAITS
#define PG8_WAIT_V(n) asm volatile("s_waitcnt vmcnt(0)" ::: "memory")
#else
#define PG8_WAIT_V(n) asm volatile("s_waitcnt vmcnt(" #n ")" ::: "memory")
#endif
#ifdef SAFE_WAITS
#define PG8_WAIT_L(n) asm volatile("s_waitcnt lgkmcnt(0)" ::: "memory")
#else
#define PG8_WAIT_L(n) asm volatile("s_waitcnt lgkmcnt(" #n ")" ::: "memory")
#endif
#define PG8_BAR do { __builtin_amdgcn_sched_barrier(0); __builtin_amdgcn_s_barrier(); __builtin_amdgcn_sched_barrier(0); } while (0)
#define PG8_SCHED __builtin_amdgcn_sched_barrier(0)
    Unit cur, nxt; int ui = 0;
    if (!S.next(0, cur)) return;
    f32x4 acc[2][2][4][2];
#pragma unroll
    for (int a = 0; a < 2; ++a)
#pragma unroll
        for (int b = 0; b < 2; ++b)
#pragma unroll
            for (int m = 0; m < 4; ++m)
#pragma unroll
                for (int n = 0; n < 2; ++n) acc[a][b][m][n] = (f32x4){0.f, 0.f, 0.f, 0.f};
    bf16x8 At[4][2], B0[2][2], B1[2][2];
#ifdef SYNC_GEMM
    const char* cA = cur.a; const char* cB = cur.b;
    for (;;) {
        const bool has_next = S.next(ui + 1, nxt);
        for (int t = 0; t < nt; ++t) {
            if constexpr (Epi::SEG) { if (t != 0 && (t & 7) == 0) E.segment(acc, cur, t >> 3, wr, wc, fr, fq); }
            const char* at = cA + (size_t)t * kstep; const char* bt = cB + (size_t)t * kstep;
            PG8_BAR;
            PG8_STAGE(PG8_SB(0, 0), bt, voffB); PG8_STAGE(PG8_SA(0, 0), at, voffA); PG8_STAGE(PG8_SB(0, 1), bt + hstepB, voffB); PG8_STAGE(PG8_SA(0, 1), at + hstepA, voffA);
            PG8_WAIT_V(0); PG8_BAR;
            PG8_LDB(B0, 0, 0); PG8_LDB(B1, 0, 1); PG8_LDA(At, 0, 0); PG8_WAIT_L(0); PG8_MMA(0, 0, At, B0); PG8_MMA(0, 1, At, B1);
            PG8_LDA(At, 0, 1); PG8_WAIT_L(0); PG8_MMA(1, 0, At, B0); PG8_MMA(1, 1, At, B1);
        }
        E(acc, cur, wr, wc, fr, fq);
        if (!has_next) break;
#pragma unroll
        for (int a = 0; a < 2; ++a)
#pragma unroll
            for (int b = 0; b < 2; ++b)
#pragma unroll
                for (int m = 0; m < 4; ++m)
#pragma unroll
                    for (int n = 0; n < 2; ++n) acc[a][b][m][n] = (f32x4){0.f, 0.f, 0.f, 0.f};
        cur = nxt; cA = cur.a; cB = cur.b; ++ui;
    }
    PG8_WAIT_V(0);
    PG8_BAR;
#else
    const char* cA = cur.a; const char* cB = cur.b;
    PG8_STAGE(PG8_SB(0, 0), cB, voffB); PG8_STAGE(PG8_SA(0, 0), cA, voffA); PG8_STAGE(PG8_SB(0, 1), cB + hstepB, voffB); PG8_STAGE(PG8_SA(0, 1), cA + hstepA, voffA);
    if (wr == 1) PG8_BAR;
    PG8_WAIT_V(4); PG8_BAR;
    PG8_STAGE(PG8_SB(1, 0), cB + kstep, voffB); PG8_STAGE(PG8_SA(1, 0), cA + kstep, voffA); PG8_STAGE(PG8_SB(1, 1), cB + hstepB + kstep, voffB);
    PG8_WAIT_V(6); PG8_BAR;
    for (;;) {
        const bool has_next = S.next(ui + 1, nxt);
        const char* nA = has_next ? nxt.a : cA; const char* nB = has_next ? nxt.b : cB;
        for (int t = 0; t < nt; t += 2) {
            const bool last = (t == nt - 2);
            if constexpr (Epi::SEG) { if (t != 0 && (t & 7) == 0) E.segment(acc, cur, t >> 3, wr, wc, fr, fq); }
            const char* a1 = cA + (size_t)(t + 1) * kstep;
            const char* a2 = last ? nA : cA + (size_t)(t + 2) * kstep; const char* b2 = last ? nB : cB + (size_t)(t + 2) * kstep;
            const char* a3 = a2 + kstep; const char* b3 = b2 + kstep;
            PG8_LDB(B0, 0, 0); PG8_SCHED; PG8_LDA(At, 0, 0); PG8_STAGE(PG8_SA(1, 1), a1 + hstepA, voffA);
            PG8_WAIT_L(8); PG8_BAR; PG8_WAIT_L(0); PG8_MMA(0, 0, At, B0); PG8_BAR; PG8_SCHED;
            PG8_LDB(B1, 0, 1); PG8_STAGE(PG8_SB(0, 0), b2, voffB);
            PG8_BAR; PG8_WAIT_L(0); PG8_MMA(0, 1, At, B1); PG8_BAR;
            PG8_LDA(At, 0, 1); PG8_STAGE(PG8_SA(0, 0), a2, voffA);
            PG8_BAR; PG8_WAIT_L(0); PG8_MMA(1, 0, At, B0); PG8_BAR; PG8_SCHED;
            PG8_STAGE(PG8_SB(0, 1), b2 + hstepB, voffB);
            PG8_WAIT_V(6); PG8_BAR; PG8_MMA(1, 1, At, B1); PG8_BAR;
            PG8_LDB(B0, 1, 0); PG8_SCHED; PG8_LDA(At, 1, 0); PG8_STAGE(PG8_SA(0, 1), a2 + hstepA, voffA);
            PG8_WAIT_L(8); PG8_BAR; PG8_WAIT_L(0); PG8_MMA(0, 0, At, B0); PG8_BAR; PG8_SCHED;
            PG8_LDB(B1, 1, 1); PG8_STAGE(PG8_SB(1, 0), b3, voffB);
            PG8_BAR; PG8_WAIT_L(0); PG8_MMA(0, 1, At, B1); PG8_BAR;
            PG8_LDA(At, 1, 1); PG8_STAGE(PG8_SA(1, 0), a3, voffA);
            PG8_BAR; PG8_WAIT_L(0); PG8_MMA(1, 0, At, B0); PG8_BAR; PG8_SCHED;
            PG8_STAGE(PG8_SB(1, 1), b3 + hstepB, voffB);
            PG8_WAIT_V(6); PG8_BAR; PG8_MMA(1, 1, At, B1); PG8_BAR;
        }
        E(acc, cur, wr, wc, fr, fq);
        if (!has_next) break;
#pragma unroll
        for (int a = 0; a < 2; ++a)
#pragma unroll
            for (int b = 0; b < 2; ++b)
#pragma unroll
                for (int m = 0; m < 4; ++m)
#pragma unroll
                    for (int n = 0; n < 2; ++n) acc[a][b][m][n] = (f32x4){0.f, 0.f, 0.f, 0.f};
        cur = nxt; cA = nA; cB = nB; ++ui;
    }
    PG8_WAIT_V(0);
    if (wr == 0) PG8_BAR;
    PG8_BAR;
#endif
#undef PG8_SA
#undef PG8_SB
#undef PG8_STAGE
#undef PG8_LDA
#undef PG8_LDB
#undef PG8_MMA
#undef PG8_WAIT_V
#undef PG8_WAIT_L
#undef PG8_BAR
#undef PG8_SCHED
}
}
using pg8::Unit;
typedef f32x4 Acc[2][2][4][2];

struct OrderInproj {
    const char* W; const char* H; int G, c;
    __device__ __forceinline__ bool next(int i, Unit& u) const {
        const int L = i * G + c; constexpr int NMAIN = 68 * 54;
        if (L >= NMAIN + 136) return false;
        if (L < NMAIN) { int pm, pn; pg8::swz_tile(L, 68, 54, pm, pn); if (pn >= 4) pn += 2;
            u.a = H + (size_t)pm * 256 * DM * 2; u.b = W + (size_t)pn * 256 * DM * 2; u.pm = pm; u.pn = pn; u.kind = 0; }
        else { const int v = L - NMAIN, pm = v & 1, pn = v >> 1;
            u.a = W + (size_t)(1024 + pm * 256) * DM * 2; u.b = H + (size_t)pn * 256 * DM * 2; u.pm = pm; u.pn = pn; u.kind = 1; }
        return true;
    }
};
struct OrderSimple {
    const char* A; const char* B; int nM, nN, lda, ldb, G, c;
    __device__ __forceinline__ bool next(int i, Unit& u) const {
        const int L = i * G + c; if (L >= nM * nN) return false;
        int pm, pn; pg8::swz_tile(L, nM, nN, pm, pn);
        u.a = A + (size_t)pm * 256 * lda * 2; u.b = B + (size_t)pn * 256 * ldb * 2; u.pm = pm; u.pn = pn; u.kind = 0; return true;
    }
};
struct OrderGroup {
    const char* X; const char* Mt; int ldb, G, c;
    __device__ __forceinline__ bool next(int i, Unit& u) const {
        const int L = i * G + c; if (L >= 160) return false;
        const int g = L / 5, r = L - g * 5;
        u.a = X + ((size_t)(g * XROWS + r * 256) * 512) * 2; u.b = Mt + (size_t)g * 256 * ldb * 2; u.pm = r; u.pn = g; u.kind = 0; return true;
    }
};

struct EpiInproj {
    static constexpr bool PERM = true, SEG = false;
    bf16_t* proj; bf16_t* vt; bf16_t* X; const float* bgate; bf16_t* R;
    __device__ __forceinline__ void operator()(const Acc& acc, const Unit& u, int wr, int wc, int fr, int fq) const {
        const int row0 = u.pm * 256 + wr * 64 + fr, col0 = u.pn * 256 + wc * 32 + 8 * fq;
        if (u.kind == 1) {
#pragma unroll
            for (int ai = 0; ai < 2; ++ai)
#pragma unroll
                for (int m = 0; m < 4; ++m) { bf16_t* rowp = vt + (size_t)(row0 + ai * 128 + m * 16) * T + col0;
#pragma unroll
                    for (int bj = 0; bj < 2; ++bj) { const f32x4 v0 = acc[ai][bj][m][0], v1 = acc[ai][bj][m][1]; u32x4 w;
                        w.x = cvt_pk_bf16(v0[0], v0[1]); w.y = cvt_pk_bf16(v0[2], v0[3]); w.z = cvt_pk_bf16(v1[0], v1[1]); w.w = cvt_pk_bf16(v1[2], v1[3]);
                        *(u32x4*)(rowp + bj * 128) = w; } }
            return;
        }
        const int pn = u.pn;
        if (pn >= 24) {
            const int ch0 = (pn - 24) * 64 + wc * 16 + fq * 4;
            f32x4 bgv[4];
#pragma unroll
            for (int br = 0; br < 4; ++br) bgv[br] = *(const f32x4*)(bgate + br * DM + ch0);
#pragma unroll
            for (int ai = 0; ai < 2; ++ai)
#pragma unroll
                for (int m = 0; m < 4; ++m) { const int row = row0 + ai * 128 + m * 16; f32x4 g[4], d[4];
                    const int cl = ch0 & 255, rl = row & 255;
                    const size_t roff = ((((((size_t)((row >> 8) * 8 + (ch0 >> 8)) * 2 + (rl >> 7)) * 4 + ((rl >> 4) & 3)) * 2 + (cl >> 7)) * 8 + (((rl >> 6) & 1) * 4 + ((cl >> 5) & 3))) * 64
                                         + ((rl & 15) + 16 * ((cl >> 3) & 3))) * 8 + (cl & 7);
#pragma unroll
                    for (int br = 0; br < 4; ++br)
#pragma unroll
                        for (int j = 0; j < 4; ++j) { d[br][j] = fminf(1.0f + __builtin_amdgcn_exp2f(-1.4426950408889634f * (acc[ai][br >> 1][m][br & 1][j] + bgv[br][j])), 1e30f); g[br][j] = __builtin_amdgcn_rcpf(d[br][j]); }
#pragma unroll
                    for (int k = 0; k < 4; ++k) { f32x4 r = g[k];
                        if (k < 3) {
#pragma unroll
                            for (int j = 0; j < 4; ++j) r[j] = g[k][j] * d[k + 1][j]; }
                        uint2 w; w.x = cvt_pk_bf16(r[0], r[1]); w.y = cvt_pk_bf16(r[2], r[3]);
                        *(uint2*)(R + (size_t)k * T * DM + roff) = w; } }
            return;
        }
        int mode = 0;
        if (pn < 2) mode = 1; else if (pn == 6 || pn == 7 || pn == 10 || pn == 11 || pn == 18 || pn == 19 || pn == 22 || pn == 23) mode = 2;
        else if (pn == 20 || pn == 21) mode = 3; else if (pn >= 24) mode = 4;
#pragma unroll
        for (int bj = 0; bj < 2; ++bj) {
            const int col = col0 + bj * 128;
            float bg[8];
#pragma unroll
            for (int e = 0; e < 8; ++e) bg[e] = 0.f;
            if (mode == 4) { const f32x4 b0 = *(const f32x4*)(bgate + col - 6144), b1 = *(const f32x4*)(bgate + col - 6144 + 4);
#pragma unroll
                for (int e = 0; e < 4; ++e) { bg[e] = b0[e]; bg[4 + e] = b1[e]; } }
#pragma unroll
            for (int ai = 0; ai < 2; ++ai)
#pragma unroll
                for (int m = 0; m < 4; ++m) {
                    const int row = row0 + ai * 128 + m * 16;
                    float v[8];
#pragma unroll
                    for (int e = 0; e < 4; ++e) { v[e] = acc[ai][bj][m][0][e]; v[4 + e] = acc[ai][bj][m][1][e]; }
                    if (mode == 1) {
#pragma unroll
                        for (int e = 0; e < 8; ++e) v[e] *= 0.125f;
                    } else if (mode == 2) {
#pragma unroll
                        for (int e = 0; e < 8; ++e) v[e] = siluf_(v[e]);
                    } else if (mode == 4) {
#pragma unroll
                        for (int e = 0; e < 8; ++e) v[e] = sigmoidf_(v[e] + bg[e]);
                    }
                    const u32x4 w = pack8(v);
                    if (mode == 3) { const int cc = col - 5120, g = cc >> 4, h0 = cc & 15, n = row >> 4, j = row & 15;
                        *(u32x4*)(X + ((size_t)(g * XROWS + n) * 512 + j * 16 + h0)) = w; }
                    else *(u32x4*)(proj + (size_t)row * NIN + col) = w;
                }
        }
    }
};
struct EpiE {
    static constexpr bool PERM = false, SEG = false;
    float* E;
    __device__ __forceinline__ void operator()(const Acc& acc, const Unit& u, int wr, int wc, int fr, int fq) const {
        const int g = u.pn, row0 = u.pm * 256 + wr * 64 + fr, col0 = wc * 32 + 4 * fq;
#pragma unroll
        for (int ai = 0; ai < 2; ++ai)
#pragma unroll
            for (int m = 0; m < 4; ++m) { const int n = row0 + ai * 128 + m * 16; if (n < NCHUNK) { float* rowp = E + (size_t)(g * XROWS + n) * 256 + col0;
#pragma unroll
                for (int bj = 0; bj < 2; ++bj)
#pragma unroll
                    for (int nn = 0; nn < 2; ++nn) *(f32x4*)(rowp + bj * 128 + nn * 16) = acc[ai][bj][m][nn]; } }
    }
};
struct EpiY {
    static constexpr bool PERM = true, SEG = false;
    bf16_t* Gb;
    __device__ __forceinline__ void operator()(const Acc& acc, const Unit& u, int wr, int wc, int fr, int fq) const {
        const int g = u.pn, row0 = u.pm * 256 + wr * 64 + fr, col0 = wc * 32 + 8 * fq;
#pragma unroll
        for (int ai = 0; ai < 2; ++ai)
#pragma unroll
            for (int m = 0; m < 4; ++m) { const int n = row0 + ai * 128 + m * 16; if (n < NCHUNK) {
#pragma unroll
                for (int bj = 0; bj < 2; ++bj) { const int col = col0 + bj * 128, t = col >> 4, h0 = col & 15; float v[8];
#pragma unroll
                    for (int e = 0; e < 4; ++e) { v[e] = gelu_tanh(acc[ai][bj][m][0][e]); v[4 + e] = gelu_tanh(acc[ai][bj][m][1][e]); }
                    *(u32x4*)(Gb + (size_t)(n * 16 + t) * 512 + g * 16 + h0) = pack8(v); } } }
    }
};
struct EpiGlu {
    static constexpr bool PERM = true, SEG = false;
    const bf16_t* proj; bf16_t* U;
    __device__ __forceinline__ void operator()(const Acc& acc, const Unit& u, int wr, int wc, int fr, int fq) const {
        const int row0 = u.pm * 256 + wr * 64 + fr, col = u.pn * 128 + wc * 32 + 8 * fq;
#pragma unroll
        for (int ai = 0; ai < 2; ++ai)
#pragma unroll
            for (int m = 0; m < 4; ++m) { const int row = row0 + ai * 128 + m * 16;
                float z[8]; unpack8(*(const u32x4*)(proj + (size_t)row * NIN + 5632 + col), z);
                float v[8];
#pragma unroll
                for (int e = 0; e < 4; ++e) { v[e] = acc[ai][0][m][0][e] * sigmoidf_(acc[ai][1][m][0][e]) * z[e]; v[4 + e] = acc[ai][0][m][1][e] * sigmoidf_(acc[ai][1][m][1][e]) * z[4 + e]; }
                *(u32x4*)(U + (size_t)row * DM + 1536 + col) = pack8(v); }
    }
};
struct EpiBranch {
    static constexpr bool PERM = true, SEG = true;
    const bf16_t* R; bf16_t* mrg;
    __device__ __forceinline__ void segment(Acc& acc, const Unit& u, int seg, int wr, int wc, int fr, int fq) const {
        int loff = (((wr * 4 + wc) * 64) + fr + 16 * fq) * 8;
        asm volatile("" : "+v"(loff));
        const bf16_t* rbase = R + (size_t)(seg - 1) * T * DM + (size_t)(u.pm * 8 + u.pn) * 65536 + loff;
        u32x4 rr[2][4][2];
#pragma unroll
        for (int ai = 0; ai < 2; ++ai)
#pragma unroll
            for (int m = 0; m < 4; ++m)
#pragma unroll
                for (int bj = 0; bj < 2; ++bj) rr[ai][m][bj] = *(const u32x4*)(rbase + ((ai * 4 + m) * 2 + bj) * 4096);
#pragma unroll
        for (int ai = 0; ai < 2; ++ai)
#pragma unroll
            for (int m = 0; m < 4; ++m)
#pragma unroll
                for (int bj = 0; bj < 2; ++bj) { float r[8]; unpack8(rr[ai][m][bj], r);
#pragma unroll
                    for (int e = 0; e < 4; ++e) { acc[ai][bj][m][0][e] *= r[e]; acc[ai][bj][m][1][e] *= r[4 + e]; } }
        __builtin_amdgcn_sched_barrier(0);
    }
    __device__ __forceinline__ void operator()(const Acc& acc, const Unit& u, int wr, int wc, int fr, int fq) const {
        const int row0 = u.pm * 256 + wr * 64 + fr, col0 = u.pn * 256 + wc * 32 + 8 * fq;
        const bf16_t* gbase = R + (size_t)3 * T * DM + (size_t)(u.pm * 8 + u.pn) * 65536 + (((wr * 4 + wc) * 64) + fr + 16 * fq) * 8;
#pragma unroll
        for (int ai = 0; ai < 2; ++ai)
#pragma unroll
            for (int m = 0; m < 4; ++m) { const int row = row0 + ai * 128 + m * 16;
#pragma unroll
                for (int bj = 0; bj < 2; ++bj) { float ga[8], v[8]; unpack8(*(const u32x4*)(gbase + ((ai * 4 + m) * 2 + bj) * 4096), ga);
#pragma unroll
                    for (int e = 0; e < 4; ++e) { v[e] = acc[ai][bj][m][0][e] * ga[e]; v[4 + e] = acc[ai][bj][m][1][e] * ga[4 + e]; }
                    *(u32x4*)(mrg + (size_t)row * DM + col0 + bj * 128) = pack8(v); } }
    }
};
struct EpiWo {
    static constexpr bool PERM = true, SEG = false;
    bf16_t* Y;
    __device__ __forceinline__ void operator()(const Acc& acc, const Unit& u, int wr, int wc, int fr, int fq) const {
        const int row0 = u.pm * 256 + wr * 64 + fr, col0 = u.pn * 256 + wc * 32 + 8 * fq;
#pragma unroll
        for (int ai = 0; ai < 2; ++ai)
#pragma unroll
            for (int m = 0; m < 4; ++m) { bf16_t* rowp = Y + (size_t)(row0 + ai * 128 + m * 16) * DM + col0;
#pragma unroll
                for (int bj = 0; bj < 2; ++bj) { const f32x4 v0 = acc[ai][bj][m][0], v1 = acc[ai][bj][m][1]; u32x4 w;
                    w.x = cvt_pk_bf16(v0[0], v0[1]); w.y = cvt_pk_bf16(v0[2], v0[3]); w.z = cvt_pk_bf16(v1[0], v1[1]); w.w = cvt_pk_bf16(v1[2], v1[3]);
                    *(u32x4*)(rowp + bj * 128) = w; } }
    }
};

__device__ void job_mod(PP p, unsigned char* smem, int job) {
    const int tid = opaque_tid(), layer = job / 48, col0 = (job % 48) * 128;
    float* cact = (float*)smem;
    float* red = cact + 5 * 2048;
    for (int i = tid; i < 5 * 2048; i += 512) { const int r = i >> 11, k = i & 2047; const float v = r < 4 ? p->c[r * 2048 + k] : p->c_ctx[k]; cact[i] = siluf_(v); }
    __syncthreads();
    const int cgp = tid & 31, ks = tid >> 5;
    float acc[5][4];
#pragma unroll
    for (int r = 0; r < 5; ++r)
#pragma unroll
        for (int j = 0; j < 4; ++j) acc[r][j] = 0.f;
    const float* wp = p->w_mod + (size_t)layer * 2048 * 6144 + col0 + cgp * 4;
#pragma unroll 4
    for (int k = ks; k < 2048; k += 16) { const f32x4 w = *(const f32x4*)(wp + (size_t)k * 6144);
#pragma unroll
        for (int r = 0; r < 5; ++r) { const float a = cact[r * 2048 + k];
#pragma unroll
            for (int j = 0; j < 4; ++j) acc[r][j] += a * w[j]; } }
#pragma unroll
    for (int r = 0; r < 5; ++r)
#pragma unroll
        for (int j = 0; j < 4; ++j) red[(ks * 5 + r) * 128 + cgp * 4 + j] = acc[r][j];
    __syncthreads();
    float* mod = (float*)(p->ws + WS_MOD);
    for (int o = tid; o < 640; o += 512) { const int r = o >> 7, cl = o & 127; float s = 0.f;
        for (int q = 0; q < 16; ++q) s += red[(q * 5 + r) * 128 + cl];
        mod[(size_t)(layer * 5 + r) * 6144 + col0 + cl] = s + p->b_mod[layer * 6144 + col0 + cl]; }
    __syncthreads();
}

__device__ void job_ssm(PP p, unsigned char* smem, int job) {
    const int tid = opaque_tid(), layer = job >> 5, g = job & 31;
    float* pw = (float*)smem;
    float* bb = pw + 2 * 17 * 64 * 2;
    float* cc = bb + 2 * 64 * 16 * 2;
    float* kk = cc + 2 * 16 * 64 * 2;
    float* dsk = kk + 2 * 16 * 16 * 16;
    if (tid < 128) {
        const int dir = tid >> 6, pp = tid & 63; const int idx = ((layer * 2 + dir) * 32 + g) * 64 + pp;
        const float are = p->a_re[idx], aim = p->a_im[idx], dt = expf(p->log_dt[(layer * 2 + dir) * 32 + g]);
        const float ex1 = are * dt, ang1 = aim * dt;
        for (int k = 0; k <= 16; ++k) { const float mag = expf(ex1 * (float)k), ang = ang1 * (float)k; const float kq = rintf(ang * 0.15915494309189535f);
            float rr = fmaf(-kq, 6.2831854820251465f, ang); rr = fmaf(-kq, -1.7484555e-7f, rr);
            pw[((dir * 17 + k) * 64 + pp) * 2 + 0] = mag * cosf(rr); pw[((dir * 17 + k) * 64 + pp) * 2 + 1] = mag * sinf(rr); }
        const float abr = pw[((dir * 17 + 1) * 64 + pp) * 2], abi = pw[((dir * 17 + 1) * 64 + pp) * 2 + 1];
        const float nr = abr - 1.0f, ni = abi, den = are * are + aim * aim;
        const float fre = (nr * are + ni * aim) / den, fim = (ni * are - nr * aim) / den;
        for (int h = 0; h < 16; ++h) { const float br = p->b_re[(size_t)idx * 16 + h], bi = p->b_im[(size_t)idx * 16 + h];
            bb[((dir * 64 + pp) * 16 + h) * 2 + 0] = fre * br - fim * bi; bb[((dir * 64 + pp) * 16 + h) * 2 + 1] = fre * bi + fim * br; }
        float* a16 = (float*)(p->ws + WS_A16);
        a16[(size_t)idx * 2 + 0] = pw[((dir * 17 + 16) * 64 + pp) * 2]; a16[(size_t)idx * 2 + 1] = pw[((dir * 17 + 16) * 64 + pp) * 2 + 1];
    }
    for (int i = tid; i < 2048; i += 512) { const int dir = i >> 10, h = (i >> 6) & 15, pp = i & 63; const size_t src = ((size_t)((layer * 2 + dir) * 32 + g) * 16 + h) * 64 + pp;
        cc[i * 2] = p->c_re[src]; cc[i * 2 + 1] = p->c_im[src]; }
    if (tid < 16) dsk[tid] = p->ssm_d[layer * 512 + g * 16 + tid];
    __syncthreads();
    {
        const int dir = tid >> 8, k = (tid >> 4) & 15, h = tid & 15;
        float acc[16];
#pragma unroll
        for (int e = 0; e < 16; ++e) acc[e] = 0.f;
        for (int pp = 0; pp < 64; ++pp) { const float cr = cc[((dir * 16 + h) * 64 + pp) * 2], ci = cc[((dir * 16 + h) * 64 + pp) * 2 + 1];
            const float ar = pw[((dir * 17 + k) * 64 + pp) * 2], ai = pw[((dir * 17 + k) * 64 + pp) * 2 + 1];
            const float car = cr * ar - ci * ai, cai = cr * ai + ci * ar;
#pragma unroll
            for (int e = 0; e < 16; ++e) acc[e] += car * bb[((dir * 64 + pp) * 16 + e) * 2] - cai * bb[((dir * 64 + pp) * 16 + e) * 2 + 1]; }
#pragma unroll
        for (int e = 0; e < 16; ++e) kk[((dir * 16 + k) * 16 + h) * 16 + e] = acc[e];
    }
    __syncthreads();
    bf16_t* Mg = (bf16_t*)(p->ws + WS_MG) + (size_t)(layer * 32 + g) * 256 * 512;
    for (int s = tid; s < 16384; s += 512) {
        const int row = s >> 6, col = (s & 63) * 8, t = row >> 4, h = row & 15; float v[8];
        if (col < 256) { const int j = col >> 4, h0 = col & 15;
#pragma unroll
            for (int e = 0; e < 8; ++e) { const int hp = h0 + e; float val = 0.f;
                if (j <= t) val += kk[((0 * 16 + (t - j)) * 16 + h) * 16 + hp];
                if (j >= t) val += kk[((1 * 16 + (j - t)) * 16 + h) * 16 + hp];
                if (j == t && hp == h) val += dsk[h];
                v[e] = val; } }
        else { const int dir = col >= 384 ? 1 : 0, pc = col - 256 - dir * 128, ri = pc >> 6, p0 = pc & 63, pwk = dir ? 16 - t : t + 1;
#pragma unroll
            for (int e = 0; e < 8; ++e) { const int pp = p0 + e; const float cr = cc[((dir * 16 + h) * 64 + pp) * 2], ci = cc[((dir * 16 + h) * 64 + pp) * 2 + 1];
                const float ar = pw[((dir * 17 + pwk) * 64 + pp) * 2], ai = pw[((dir * 17 + pwk) * 64 + pp) * 2 + 1];
                v[e] = ri ? -(cr * ai + ci * ar) : (cr * ar - ci * ai); } }
        *(u32x4*)(Mg + (size_t)row * 512 + col) = pack8(v);
    }
    bf16_t* Wg = (bf16_t*)(p->ws + WS_WG) + (size_t)(layer * 32 + g) * 256 * 256;
    for (int s = tid; s < 8192; s += 512) {
        const int row = s >> 5, col = (s & 31) * 8, dir = row >> 7, ri = (row >> 6) & 1, pp = row & 63, j = col >> 4, h0 = col & 15, ek = dir ? j : 15 - j;
        const float ar = pw[((dir * 17 + ek) * 64 + pp) * 2], ai = pw[((dir * 17 + ek) * 64 + pp) * 2 + 1]; float v[8];
#pragma unroll
        for (int e = 0; e < 8; ++e) { const float br = bb[((dir * 64 + pp) * 16 + h0 + e) * 2], bi = bb[((dir * 64 + pp) * 16 + h0 + e) * 2 + 1];
            v[e] = ri ? (ar * bi + ai * br) : (ar * br - ai * bi); }
        *(u32x4*)(Wg + (size_t)row * 256 + col) = pack8(v);
    }
    __syncthreads();
}

__device__ void job_fold(PP p, unsigned char* smem, int job) {
    const int tid = opaque_tid(), layer = job >> 7, gi = (job >> 5) & 3, k0 = (job & 31) * 64;
    float* wt = (float*)smem;
    float* pl = wt + 64 * 128;
    const float* src = p->w_in + (size_t)layer * DM * NIN + (size_t)k0 * NIN + 2048 + gi * 128;
#pragma unroll
    for (int i = 0; i < 4; ++i) { const int idx = tid + i * 512, k = idx >> 5, c4 = idx & 31; *(f32x4*)(wt + k * 128 + c4 * 4) = *(const f32x4*)(src + (size_t)k * NIN + c4 * 4); }
    const float* ps = p->pool_w + (size_t)(layer * 4 + gi) * 128 * 128;
#pragma unroll
    for (int i = 0; i < 8; ++i) { const int idx = tid + i * 512; *(f32x4*)(pl + idx * 4) = *(const f32x4*)(ps + idx * 4); }
    __syncthreads();
    const int d = tid & 127, kg = tid >> 7;
    float acc[16];
#pragma unroll
    for (int e = 0; e < 16; ++e) acc[e] = 0.f;
    for (int c = 0; c < 128; ++c) { const float w = pl[c * 128 + d];
#pragma unroll
        for (int e = 0; e < 16; ++e) acc[e] += wt[(kg * 16 + e) * 128 + c] * w; }
    const float sc = p->pool_scale[layer * 512 + gi * 128 + d];
    float v0[8], v1[8];
#pragma unroll
    for (int e = 0; e < 8; ++e) { v0[e] = acc[e] * sc; v1[e] = acc[8 + e] * sc; }
    bf16_t* dst = (bf16_t*)(p->ws + WS_WINT) + (size_t)layer * NIN * DM + (size_t)(2048 + gi * 128 + d) * DM + k0 + kg * 16;
    *(u32x4*)dst = pack8(v0); *(u32x4*)(dst + 8) = pack8(v1);
    __syncthreads();
}

__device__ void transpose_tile(const float* src, int srcld, int r0, int c0, bf16_t* dst, int dstld, int glu, unsigned char* smem) {
    const int tid = opaque_tid(); float* tile = (float*)smem;
    f32x4 v[8];
#pragma unroll
    for (int i = 0; i < 8; ++i) { const int idx = tid + i * 512, r = idx >> 6, c4 = idx & 63; v[i] = *(const f32x4*)(src + (size_t)(r0 + r) * srcld + c0 + c4 * 4); }
#pragma unroll
    for (int i = 0; i < 8; ++i) { const int idx = tid + i * 512, r = idx >> 6, c4 = idx & 63; *(f32x4*)(tile + r * 260 + ((c4 ^ (r >> 3)) << 2)) = v[i]; }
    __syncthreads();
#pragma unroll
    for (int i = 0; i < 4; ++i) { const int id = tid + i * 512, r8 = id & 7, c = id >> 3; float f[8];
#pragma unroll
        for (int e = 0; e < 8; ++e) f[e] = tile[(r8 * 8 + e) * 260 + ((((c >> 2) ^ r8) << 2) | (c & 3))];
        int drow = c0 + c;
        if (glu == 1) { drow = (drow < 512) ? ((drow >> 7) * 256 + (drow & 127)) : ((((drow - 512) >> 7) * 256) + 128 + ((drow - 512) & 127)); }
        else if (glu == 2 && drow >= 6144) {
            const int cc = drow - 6144, br = cc >> 11, ch = cc & 2047, pnl = ch >> 6, chl = ch & 63;
            drow = 6144 + 256 * pnl + 128 * (br >> 1) + 32 * (chl >> 4) + 8 * ((chl >> 2) & 3) + 4 * (br & 1) + (chl & 3); }
        *(u32x4*)(dst + (size_t)drow * dstld + r0 + r8 * 8) = pack8(f); }
    __syncthreads();
}

__device__ __forceinline__ void prep_layer_jobs(PP p, unsigned char* smem, int layer, int start, int stride, int jlo, int jhi) {
    for (int j = jlo + start; j < jhi; j += stride) {
        if (j < 48) job_mod(p, smem, layer * 48 + j);
        else if (j < 80) job_ssm(p, smem, layer * 32 + (j - 48));
        else if (j < 208) job_fold(p, smem, layer * 128 + (j - 80));
        else if (j < 2000) { const int rem = j - 208, rt = rem / 56, ct = rem % 56; if (ct == 8 || ct == 9) continue;
            transpose_tile(p->w_in + (size_t)layer * DM * NIN, NIN, rt * 64, ct * 256, (bf16_t*)(p->ws + WS_WINT) + (size_t)layer * NIN * DM, DM, 2, smem); }
        else if (j < 2256) { const int rem = j - 2000, rt = rem >> 3, ct = rem & 7;
            transpose_tile(p->w_br + (size_t)layer * DM * DM, DM, rt * 64, ct * 256, (bf16_t*)(p->ws + WS_WBRT) + (size_t)layer * DM * DM, DM, 0, smem); }
        else if (j < 2512) { const int rem = j - 2256, rt = rem >> 3, ct = rem & 7;
            transpose_tile(p->w_o + (size_t)layer * DM * DM, DM, rt * 64, ct * 256, (bf16_t*)(p->ws + WS_WOT) + (size_t)layer * DM * DM, DM, 0, smem); }
        else { const int rem = j - 2512, rt = rem >> 2, ct = rem & 3;
            transpose_tile(p->glu_w + (size_t)layer * 512 * 1024, 1024, rt * 64, ct * 256, (bf16_t*)(p->ws + WS_GLUT) + (size_t)layer * 1024 * 512, 512, 1, smem); }
    }
}

__device__ __forceinline__ float wave_sum(float v) {
#pragma unroll
    for (int o = 32; o >= 1; o >>= 1) v += __shfl_xor(v, o);
    return v;
}
__device__ __forceinline__ void norm_row(int layer, const float* xin, float* xst, const bf16_t* yrow, bf16_t* hrow, const float* sm, const float* smb, int lane) {
    f32x4 xv[8];
#pragma unroll
    for (int q = 0; q < 8; ++q) xv[q] = *(const f32x4*)(xin + (q * 64 + lane) * 4);
    if (layer >= 1) {
        f32x4 yv[8]; float ss = 0.f;
#pragma unroll
        for (int q = 0; q < 8; ++q) { const uint2 yw = *(const uint2*)(yrow + (q * 64 + lane) * 4); yv[q] = (f32x4){bflo(yw.x), bfhi(yw.x), bflo(yw.y), bfhi(yw.y)}; ss += yv[q][0] * yv[q][0] + yv[q][1] * yv[q][1] + yv[q][2] * yv[q][2] + yv[q][3] * yv[q][3]; }
        ss = wave_sum(ss); const float rs = rsqrtf(ss * (1.0f / DM) + 1e-6f);
#pragma unroll
        for (int q = 0; q < 8; ++q) { const int col = (q * 64 + lane) * 4; const f32x4 gt = *(const f32x4*)(smb + 2 * DM + col), gg = *(const f32x4*)(sm + DM + col);
#pragma unroll
            for (int e = 0; e < 4; ++e) xv[q][e] += gt[e] * (yv[q][e] * rs * gg[e]);
            *(f32x4*)(xst + col) = xv[q]; }
    }
    if (layer < 4) {
        float ss = 0.f;
#pragma unroll
        for (int q = 0; q < 8; ++q) ss += xv[q][0] * xv[q][0] + xv[q][1] * xv[q][1] + xv[q][2] * xv[q][2] + xv[q][3] * xv[q][3];
        ss = wave_sum(ss); const float rs = rsqrtf(ss * (1.0f / DM) + 1e-6f);
#pragma unroll
        for (int q = 0; q < 8; ++q) { const int col = (q * 64 + lane) * 4; const f32x4 sh = *(const f32x4*)(smb + col), sc = *(const f32x4*)(smb + DM + col), gg = *(const f32x4*)(sm + col);
            float h[4];
#pragma unroll
            for (int e = 0; e < 4; ++e) h[e] = (xv[q][e] * rs * gg[e]) * (1.0f + sc[e]) + sh[e];
            uint2 w; w.x = cvt_pk_bf16(h[0], h[1]); w.y = cvt_pk_bf16(h[2], h[3]);
            *(uint2*)(hrow + col) = w; }
    }
}
__device__ void norm_phase(PP p, int layer, unsigned char* smem) {
    const int tid = opaque_tid(), wid = tid >> 6, lane = tid & 63, blk = blockIdx.x;
    const float* mod = (const float*)(p->ws + WS_MOD);
    const bf16_t* Y = (const bf16_t*)(p->ws + WS_Y);
    bf16_t* H = (bf16_t*)(p->ws + WS_H);
    float* XC = (float*)(p->ws + WS_XC);
    float* sm = (float*)smem;
    const int b = (blk * 64) >> 12;
    for (int i = tid; i < DM / 4; i += 512) { const int c4 = i * 4;
        if (layer < 4) { *(f32x4*)(sm + c4) = *(const f32x4*)(p->g_pre + layer * DM + c4);
            *(f32x4*)(sm + 2 * DM + c4) = *(const f32x4*)(mod + (size_t)(layer * 5 + b) * 6144 + c4); *(f32x4*)(sm + 3 * DM + c4) = *(const f32x4*)(mod + (size_t)(layer * 5 + b) * 6144 + DM + c4);
            *(f32x4*)(sm + 5 * DM + c4) = *(const f32x4*)(mod + (size_t)(layer * 5 + 4) * 6144 + c4); *(f32x4*)(sm + 6 * DM + c4) = *(const f32x4*)(mod + (size_t)(layer * 5 + 4) * 6144 + DM + c4); }
        if (layer >= 1) { *(f32x4*)(sm + DM + c4) = *(const f32x4*)(p->g_post + (layer - 1) * DM + c4);
            *(f32x4*)(sm + 4 * DM + c4) = *(const f32x4*)(mod + (size_t)((layer - 1) * 5 + b) * 6144 + 2 * DM + c4); *(f32x4*)(sm + 7 * DM + c4) = *(const f32x4*)(mod + (size_t)((layer - 1) * 5 + 4) * 6144 + 2 * DM + c4); } }
    __syncthreads();
    for (int i = 0; i < 8; ++i) { const int row = blk * 64 + wid * 8 + i;
        float* xst = p->out + (size_t)row * DM; const float* xin = (layer <= 1) ? p->x + (size_t)row * DM : xst;
        norm_row(layer, xin, xst, Y + (size_t)row * DM, H + (size_t)row * DM, sm, sm + 2 * DM, lane); }
    if (layer < 4 && (wid & 1) == 0) { const int cr = blk * 4 + (wid >> 1), row = TLAT + cr;
        float* xst = XC + (size_t)cr * DM; const float* xin = (layer <= 1) ? p->ctx + (size_t)cr * DM : xst;
        norm_row(layer, xin, xst, Y + (size_t)row * DM, H + (size_t)row * DM, sm, sm + 5 * DM, lane); }
    __syncthreads();
}

__device__ void attn_phase(PP p, int layer) {
    const int tid = opaque_tid(), wid = tid >> 6, lane = tid & 63, qi = lane & 15, quad = lane >> 4;
    const bf16_t* PROJ = (const bf16_t*)(p->ws + WS_PROJ); const bf16_t* VT = (const bf16_t*)(p->ws + WS_VT); bf16_t* U = (bf16_t*)(p->ws + WS_U);
    const int ntask = 8192 + (layer < 3 ? 512 : 0);
    for (int task = blockIdx.x * 8 + wid; task < ntask; task += gridDim.x * 8) {
        int b, head, tq0, nband, r = 0, ct = 0, rs = 0, cs = 0;
        if (task < 8192) { ct = task & 3; r = (task >> 2) & 63; head = (task >> 8) & 7; b = task >> 11; tq0 = b * SEQ + r * 64 + ct * 16;
            rs = min(max(r - 4, 0), 56); cs = min(max(ct * 16 - 8, 0), 32); nband = 8; }
        else { const int t2 = task - 8192; head = (t2 >> 4) & 7; b = t2 >> 7; tq0 = TLAT + b * NCTX + (t2 & 15) * 16; nband = 0; }
        const bf16_t* qp = PROJ + (size_t)(tq0 + qi) * NIN + head * 64 + quad * 8;
        const bf16x8 qf0 = *(const bf16x8*)qp, qf1 = *(const bf16x8*)(qp + 32);
        f32x4 O[4];
#pragma unroll
        for (int dt = 0; dt < 4; ++dt) O[dt] = (f32x4){0.f, 0.f, 0.f, 0.f};
        float mrun = -1e30f, lrun = 0.f;
        const int qcol = ct * 16 + qi, start = min(max(qcol - 8, 0), 48);
        const float* rpbh = p->na_rpb + (size_t)(layer * 8 + head) * 15 * 31;
        const int kidx0 = (qi >> 2) * 8 + (qi & 3);
        const int nblk = nband + 8;
        for (int blk = 0; blk < nblk; blk += 2) {
            const bool band = blk < nband;
            bf16x8 kf[2][4], vf[2][4]; float sc[16];
#pragma unroll
            for (int h = 0; h < 2; ++h) {
                const int bb = blk + h;
                const int kb = band ? b * SEQ + (rs + bb) * 64 + cs : TLAT + b * NCTX + (bb - nband) * 32;
                const bf16_t* kp = PROJ + (size_t)(kb + kidx0) * NIN + 512 + head * 64 + quad * 8;
                kf[h][0] = *(const bf16x8*)kp; kf[h][1] = *(const bf16x8*)(kp + 32); kf[h][2] = *(const bf16x8*)(kp + 4 * NIN); kf[h][3] = *(const bf16x8*)(kp + 4 * NIN + 32);
                const bf16_t* vp = VT + (size_t)(head * 64 + qi) * T + kb + quad * 8;
#pragma unroll
                for (int dt = 0; dt < 4; ++dt) vf[h][dt] = *(const bf16x8*)(vp + (size_t)dt * 16 * T);
#pragma unroll
                for (int e = 0; e < 8; ++e) { float bias = 0.f;
                    if (band) { const int dcol = min(max(cs + quad * 8 + e - qcol + 15, 0), 30); bias = rpbh[(rs + bb - r + 7) * 31 + dcol]; }
                    sc[h * 8 + e] = bias; }
            }
#pragma unroll
            for (int h = 0; h < 2; ++h) {
                f32x4 s0 = (f32x4){0.f, 0.f, 0.f, 0.f}, s1 = (f32x4){0.f, 0.f, 0.f, 0.f};
                s0 = __builtin_amdgcn_mfma_f32_16x16x32_bf16(kf[h][0], qf0, s0, 0, 0, 0); s0 = __builtin_amdgcn_mfma_f32_16x16x32_bf16(kf[h][1], qf1, s0, 0, 0, 0);
                s1 = __builtin_amdgcn_mfma_f32_16x16x32_bf16(kf[h][2], qf0, s1, 0, 0, 0); s1 = __builtin_amdgcn_mfma_f32_16x16x32_bf16(kf[h][3], qf1, s1, 0, 0, 0);
#pragma unroll
                for (int e = 0; e < 8; ++e) { float sv = ((e < 4) ? s0[e & 3] : s1[e & 3]) + sc[h * 8 + e];
                    if (band) { const int kcol = cs + quad * 8 + e; const bool ok = (kcol >= start) && (kcol < start + 16); sv = ok ? sv : -1e30f; }
                    sc[h * 8 + e] = sv; }
            }
            float mx = sc[0];
#pragma unroll
            for (int e = 1; e < 16; ++e) mx = fmaxf(mx, sc[e]);
            mx = fmaxf(mx, __shfl_xor(mx, 16)); mx = fmaxf(mx, __shfl_xor(mx, 32));
            const float mnew = fmaxf(mrun, mx), alpha = __expf(mrun - mnew);
            float ps = 0.f, pv[16];
#pragma unroll
            for (int e = 0; e < 16; ++e) { pv[e] = __expf(sc[e] - mnew); ps += pv[e]; }
            lrun = lrun * alpha + ps; mrun = mnew;
#pragma unroll
            for (int jj = 0; jj < 4; ++jj) { const float aj = __shfl(alpha, quad * 4 + jj);
#pragma unroll
                for (int dt = 0; dt < 4; ++dt) O[dt][jj] *= aj; }
#pragma unroll
            for (int h = 0; h < 2; ++h) { float ph[8];
#pragma unroll
                for (int e = 0; e < 8; ++e) ph[e] = pv[h * 8 + e];
                const u32x4 pw4 = pack8(ph); bf16x8 pf; __builtin_memcpy(&pf, &pw4, 16);
#pragma unroll
                for (int dt = 0; dt < 4; ++dt) O[dt] = __builtin_amdgcn_mfma_f32_16x16x32_bf16(pf, vf[h][dt], O[dt], 0, 0, 0); }
        }
        float ltot = lrun + __shfl_xor(lrun, 16); ltot += __shfl_xor(ltot, 32);
        const float inv = 1.0f / ltot;
#pragma unroll
        for (int jj = 0; jj < 4; ++jj) { const float ij = __shfl(inv, quad * 4 + jj); const int tok = tq0 + quad * 4 + jj;
#pragma unroll
            for (int dt = 0; dt < 4; ++dt) { const int d = dt * 16 + qi; const float z = bf2f(PROJ[(size_t)tok * NIN + 1536 + head * 64 + d]);
                U[(size_t)tok * DM + head * 64 + d] = f2bf(O[dt][jj] * ij * z); } }
    }
}

__device__ void elem_phase(PP p, int layer) {
    const bf16_t* __restrict__ PROJ = (const bf16_t*)(p->ws + WS_PROJ); bf16_t* __restrict__ U = (bf16_t*)(p->ws + WS_U);
    const int nitems = (TLAT / 16) * 128;
    for (int it = blockIdx.x * 512 + opaque_tid(); it < nitems; it += gridDim.x * 512) {
        const int chunk = it >> 7, cgp = it & 127, tok0 = chunk * 16;
        int l0, L; if (tok0 < TLAT) { l0 = tok0 & (SEQ - 1); L = SEQ; } else { l0 = (tok0 - TLAT) & (NCTX - 1); L = NCTX; }
        const int seq0 = tok0 - l0;
        if (cgp < 64) {
            const int c0 = cgp * 8, gi = c0 >> 7, w = 2 << gi, hw = w >> 1;
            const bf16_t* ub = PROJ + (size_t)seq0 * NIN + 2048 + c0;
            int lo = max(l0 - hw, 0), hi = min(l0 + w - hw, L);
            float s[8];
#pragma unroll
            for (int e = 0; e < 8; ++e) s[e] = 0.f;
            for (int tt = lo; tt < hi; ++tt) { float f[8]; unpack8(*(const u32x4*)(ub + (size_t)tt * NIN), f);
#pragma unroll
                for (int e = 0; e < 8; ++e) s[e] += f[e]; }
#pragma unroll 4
            for (int i = 0; i < 16; ++i) { const int l = l0 + i;
                float self[8], z[8]; unpack8(*(const u32x4*)(ub + (size_t)l * NIN), self); unpack8(*(const u32x4*)(ub + (size_t)l * NIN + 512), z);
                const float ic = 1.0f / (float)(hi - lo); float o[8];
#pragma unroll
                for (int e = 0; e < 8; ++e) o[e] = (s[e] * ic - self[e]) * z[e];
                *(u32x4*)(U + (size_t)(seq0 + l) * DM + 512 + c0) = pack8(o);
                const int nhi = min(l + 1 + w - hw, L), nlo = max(l + 1 - hw, 0);
                if (nhi > hi) { float f[8]; unpack8(*(const u32x4*)(ub + (size_t)hi * NIN), f);
#pragma unroll
                    for (int e = 0; e < 8; ++e) s[e] += f[e];
                    hi = nhi; }
                if (nlo > lo) { float f[8]; unpack8(*(const u32x4*)(ub + (size_t)lo * NIN), f);
#pragma unroll
                    for (int e = 0; e < 8; ++e) s[e] -= f[e];
                    lo = nlo; } }
        } else {
            const int c0 = (cgp - 64) * 8; const bf16_t* base = PROJ + (size_t)seq0 * NIN + c0;
            const float* cw = p->conv_w + (size_t)layer * 3 * 512 + c0;
            float w0[8], w1[8], w2[8];
#pragma unroll
            for (int e = 0; e < 8; ++e) { w0[e] = cw[e]; w1[e] = cw[512 + e]; w2[e] = cw[1024 + e]; }
            float xm[8], x0[8], xp[8];
            if (l0 > 0) { float a[8], c[8]; unpack8(*(const u32x4*)(base + (size_t)(l0 - 1) * NIN + 3072), a); unpack8(*(const u32x4*)(base + (size_t)(l0 - 1) * NIN + 4096), c);
#pragma unroll
                for (int e = 0; e < 8; ++e) xm[e] = a[e] * c[e]; }
            else {
#pragma unroll
                for (int e = 0; e < 8; ++e) xm[e] = 0.f; }
            { float a[8], c[8]; unpack8(*(const u32x4*)(base + (size_t)l0 * NIN + 3072), a); unpack8(*(const u32x4*)(base + (size_t)l0 * NIN + 4096), c);
#pragma unroll
                for (int e = 0; e < 8; ++e) x0[e] = a[e] * c[e]; }
#pragma unroll 4
            for (int i = 0; i < 16; ++i) { const int l = l0 + i;
                if (l < L - 1) { float a[8], c[8]; unpack8(*(const u32x4*)(base + (size_t)(l + 1) * NIN + 3072), a); unpack8(*(const u32x4*)(base + (size_t)(l + 1) * NIN + 4096), c);
#pragma unroll
                    for (int e = 0; e < 8; ++e) xp[e] = a[e] * c[e]; }
                else {
#pragma unroll
                    for (int e = 0; e < 8; ++e) xp[e] = 0.f; }
                float gb[8], z[8]; unpack8(*(const u32x4*)(base + (size_t)l * NIN + 3584), gb); unpack8(*(const u32x4*)(base + (size_t)l * NIN + 4608), z);
                float o[8];
#pragma unroll
                for (int e = 0; e < 8; ++e) o[e] = gb[e] * (w0[e] * xm[e] + w1[e] * x0[e] + w2[e] * xp[e]) * z[e];
                *(u32x4*)(U + (size_t)(seq0 + l) * DM + 1024 + c0) = pack8(o);
#pragma unroll
                for (int e = 0; e < 8; ++e) { xm[e] = x0[e]; x0[e] = xp[e]; } }
        }
    }
}

__device__ void elem_ctx_tokens(PP p, int layer) {
    const bf16_t* __restrict__ PROJ = (const bf16_t*)(p->ws + WS_PROJ); bf16_t* __restrict__ U = (bf16_t*)(p->ws + WS_U);
    const int nitems = TCTX * 128;
#pragma unroll 2
    for (int it = blockIdx.x * 512 + opaque_tid(); it < nitems; it += gridDim.x * 512) {
        const int tok = TLAT + (it >> 7), cgp = it & 127;
        int l, L; if (tok < TLAT) { l = tok & (SEQ - 1); L = SEQ; } else { l = (tok - TLAT) & (NCTX - 1); L = NCTX; }
        const int seq0 = tok - l;
        if (cgp < 64) {
            const int c0 = cgp * 8, gi = c0 >> 7, w = 2 << gi, lo = max(l - (w >> 1), 0), hi = min(l + w - (w >> 1), L);
            float s[8];
#pragma unroll
            for (int e = 0; e < 8; ++e) s[e] = 0.f;
            for (int tt = lo; tt < hi; ++tt) { float f[8]; unpack8(*(const u32x4*)(PROJ + (size_t)(seq0 + tt) * NIN + 2048 + c0), f);
#pragma unroll
                for (int e = 0; e < 8; ++e) s[e] += f[e]; }
            float self[8], z[8]; unpack8(*(const u32x4*)(PROJ + (size_t)tok * NIN + 2048 + c0), self); unpack8(*(const u32x4*)(PROJ + (size_t)tok * NIN + 2560 + c0), z);
            const float ic = 1.0f / (float)(hi - lo); float o[8];
#pragma unroll
            for (int e = 0; e < 8; ++e) o[e] = (s[e] * ic - self[e]) * z[e];
            *(u32x4*)(U + (size_t)tok * DM + 512 + c0) = pack8(o);
        } else {
            const int c0 = (cgp - 64) * 8; const bf16_t* base = PROJ + (size_t)tok * NIN + c0;
            float xm[8], x0[8], xp[8], cm[8], c0v[8], cp[8], gb[8], z[8];
            unpack8(*(const u32x4*)(base + 3072), x0); unpack8(*(const u32x4*)(base + 4096), c0v); unpack8(*(const u32x4*)(base + 3584), gb); unpack8(*(const u32x4*)(base + 4608), z);
            if (l > 0) { unpack8(*(const u32x4*)(base - NIN + 3072), xm); unpack8(*(const u32x4*)(base - NIN + 4096), cm); }
            else {
#pragma unroll
                for (int e = 0; e < 8; ++e) { xm[e] = 0.f; cm[e] = 0.f; } }
            if (l < L - 1) { unpack8(*(const u32x4*)(base + NIN + 3072), xp); unpack8(*(const u32x4*)(base + NIN + 4096), cp); }
            else {
#pragma unroll
                for (int e = 0; e < 8; ++e) { xp[e] = 0.f; cp[e] = 0.f; } }
            const float* cw = p->conv_w + (size_t)layer * 3 * 512 + c0; float o[8];
#pragma unroll
            for (int e = 0; e < 8; ++e) o[e] = gb[e] * (cw[e] * (xm[e] * cm[e]) + cw[512 + e] * (x0[e] * c0v[e]) + cw[1024 + e] * (xp[e] * cp[e])) * z[e];
            *(u32x4*)(U + (size_t)tok * DM + 1024 + c0) = pack8(o);
        }
    }
}

__device__ void carry_phase(PP p, int layer) {
    const int id = (gridDim.x - 1 - blockIdx.x) * 512 + opaque_tid(); if (id >= 16384) return;
    const int pp = id & 63, g = (id >> 6) & 31, dir = (id >> 11) & 1, b = id >> 12;
    const float* a16 = (const float*)(p->ws + WS_A16) + (size_t)(((layer * 2 + dir) * 32 + g) * 64 + pp) * 2;
    const float ar = a16[0], ai = a16[1];
    const float* E = (const float*)(p->ws + WS_E) + (size_t)g * XROWS * 256 + dir * 128 + pp;
    bf16_t* X = (bf16_t*)(p->ws + WS_X) + (size_t)g * XROWS * 512 + 256 + dir * 128 + pp;
    float sr = 0.f, si = 0.f;
    for (int s0 = 0; s0 < 272; s0 += 8) {
        float er[8], ei[8]; int nn[8];
#pragma unroll
        for (int q = 0; q < 8; ++q) { const int s = s0 + q; int n;
            if (s < 16) n = 1024 + b * 16 + (dir ? 15 - s : s); else n = b * 256 + (dir ? 255 - (s - 16) : (s - 16));
            nn[q] = n; er[q] = E[(size_t)n * 256]; ei[q] = E[(size_t)n * 256 + 64]; }
#pragma unroll
        for (int q = 0; q < 8; ++q) { X[(size_t)nn[q] * 512] = f2bf(sr); X[(size_t)nn[q] * 512 + 64] = f2bf(si);
            const float nr = ar * sr - ai * si + er[q], ni = ar * si + ai * sr + ei[q]; sr = nr; si = ni; }
    }
}

#define XB_TMO      128
#define XB_XCNT(j)  (256  + 64 * (j))
#define XB_XSUB(j)  (1280 + 64 * (j))
#define XB_XGEN(j)  (2304 + 64 * (j))
#define XB_TOP      3328
#define XB_TOPGEN   3392
#define XCD_BAR_WORDS 3456
#define XB_SPIN_CAP (1u << 18)
__device__ __forceinline__ unsigned xb_ld(unsigned* p)              { return __hip_atomic_load(p, __ATOMIC_RELAXED, __HIP_MEMORY_SCOPE_AGENT); }
__device__ __forceinline__ unsigned xb_add(unsigned* p, unsigned v) { return __hip_atomic_fetch_add(p, v, __ATOMIC_RELAXED, __HIP_MEMORY_SCOPE_AGENT); }
__device__ __forceinline__ unsigned xb_xcc_id() { return (unsigned)__builtin_amdgcn_s_getreg((3 << 11) | 20) & 0xFu; }
#define XB_SPIN(cond, bar) do { unsigned _sp = 0; while (cond) { __builtin_amdgcn_s_sleep(1); \
    if ((++_sp & 255u) == 0u) { if (xb_ld(&(bar)[XB_TMO])) break; if (_sp > XB_SPIN_CAP) { atomicAdd(&(bar)[XB_TMO], 1u); break; } } } } while (0)
__device__ __forceinline__ void xcd_barrier_complete(unsigned* bar, unsigned x, unsigned& nloc, unsigned& nx) {
    const unsigned G = gridDim.x;
    unsigned sum, cnt, mine, sp = 0u;
    for (;;) {
        sum = 0u; cnt = 0u; mine = 0u;
#pragma unroll
        for (unsigned j = 0; j < 16; ++j) { const unsigned c = xb_ld(&bar[XB_XCNT(j)]); sum += c; cnt += (c > 0u) ? 1u : 0u; mine = (j == x) ? c : mine; }
        if (sum == G) break;
        __builtin_amdgcn_s_sleep(1);
        if ((++sp & 255u) == 0u) { if (xb_ld(&bar[XB_TMO])) break; if (sp > XB_SPIN_CAP) { atomicAdd(&bar[XB_TMO], 1u); break; } }
    }
    nloc = mine > 0u ? mine : 1u; nx = cnt > 0u ? cnt : 1u;
}
__device__ __forceinline__ void xcd_barrier(unsigned* bar, volatile LAS unsigned* st) {
    asm volatile("s_waitcnt vmcnt(0)" ::: "memory");
    __syncthreads();
    if (threadIdx.x == 0) {
        __builtin_amdgcn_s_waitcnt(0);
        const unsigned x = xb_xcc_id();
        unsigned nloc = st[0], nx = st[1];
        if (nloc == 0u) { xcd_barrier_complete(bar, x, nloc, nx); st[0] = nloc; st[1] = nx; }
        const unsigned old = xb_add(&bar[XB_XSUB(x)], 1u);
        const unsigned gen = old / nloc;
        if (old + 1u == (gen + 1u) * nloc) {
            __builtin_amdgcn_fence(__ATOMIC_RELEASE, "agent");
            asm volatile("s_waitcnt vmcnt(0)" ::: "memory");
            const unsigned og = xb_add(&bar[XB_TOP], 1u);
            const unsigned tg = og / nx;
            if (og + 1u == (tg + 1u) * nx) xb_add(&bar[XB_TOPGEN], 1u);
            else XB_SPIN(xb_ld(&bar[XB_TOPGEN]) == tg, bar);
            __builtin_amdgcn_fence(__ATOMIC_ACQUIRE, "agent");
            xb_add(&bar[XB_XGEN(x)], 1u);
            asm volatile("s_waitcnt vmcnt(0)" ::: "memory");
        } else {
            XB_SPIN(xb_ld(&bar[XB_XGEN(x)]) == gen, bar);
            __builtin_amdgcn_fence(__ATOMIC_ACQUIRE, "agent");
            asm volatile("s_waitcnt vmcnt(0)" ::: "memory");
        }
    }
    __syncthreads();
}

template <int PMASK> __device__ __forceinline__ void run_phase(PP p, int ph, unsigned char* smem) {
    LAS unsigned char* lds = (LAS unsigned char*)smem;
    const int G = gridDim.x, c = blockIdx.x;
    if (ph == 0) { if constexpr ((PMASK >> 8) & 1) prep_layer_jobs(p, smem, 0, blockIdx.x, gridDim.x, 0, 2544); return; }
    if (ph == 33) { if constexpr ((PMASK >> 0) & 1) norm_phase(p, 4, smem); return; }
    const int layer = (ph - 1) >> 3, sub = (ph - 1) & 7;
    const char* ws = (const char*)p->ws;
    switch (sub) {
    case 0: if constexpr ((PMASK >> 0) & 1) norm_phase(p, layer, smem); break;
    case 1: if constexpr ((PMASK >> 1) & 1) { OrderInproj S{ws + WS_WINT + (size_t)layer * NIN * DM * 2, ws + WS_H, G, c};
        EpiInproj Ep{(bf16_t*)(p->ws + WS_PROJ), (bf16_t*)(p->ws + WS_VT), (bf16_t*)(p->ws + WS_X), p->b_gate + layer * 8192, (bf16_t*)(p->ws + WS_R)};
        pg8::gemm_phase(lds, pg8::Gemm{DM, DM, DM}, S, Ep); } break;
    case 2: if constexpr ((PMASK >> 2) & 1) { OrderGroup S{ws + WS_X, ws + WS_WG + (size_t)layer * 32 * 256 * 256 * 2, 256, G, c};
        EpiE Ep{(float*)(p->ws + WS_E)};
        pg8::gemm_phase(lds, pg8::Gemm{512, 256, 256}, S, Ep); } break;
    case 3: if constexpr ((PMASK >> 3) & 1) { carry_phase(p, layer); attn_phase(p, layer); elem_phase(p, layer); if (layer < 3) elem_ctx_tokens(p, layer);
#ifdef DUP3
        if (DUP3 & 1) carry_phase(p, layer);
        if (DUP3 & 2) attn_phase(p, layer);
        if (DUP3 & 4) elem_phase(p, layer);
#endif
        } break;
    case 4: if constexpr ((PMASK >> 4) & 1) { OrderGroup S{ws + WS_X, ws + WS_MG + (size_t)layer * 32 * 256 * 512 * 2, 512, G, c};
        EpiY Ep{(bf16_t*)(p->ws + WS_G)};
        pg8::gemm_phase(lds, pg8::Gemm{512, 512, 512}, S, Ep); } break;
    case 5: if constexpr ((PMASK >> 5) & 1) { OrderSimple S{ws + WS_G, ws + WS_GLUT + (size_t)layer * 1024 * 512 * 2, layer == 3 ? 64 : 68, 4, 512, 512, G, c};
        EpiGlu Ep{(const bf16_t*)(p->ws + WS_PROJ), (bf16_t*)(p->ws + WS_U)};
        pg8::gemm_phase(lds, pg8::Gemm{512, 512, 512}, S, Ep); } break;
    case 6: if constexpr ((PMASK >> 6) & 1) { OrderSimple S{ws + WS_U, ws + WS_WBRT + (size_t)layer * DM * DM * 2, layer == 3 ? 64 : 68, 8, DM, DM, G, c};
        EpiBranch Ep{(const bf16_t*)(p->ws + WS_R), (bf16_t*)(p->ws + WS_MRG)};
        pg8::gemm_phase(lds, pg8::Gemm{DM, DM, DM}, S, Ep);
        if (layer < 3 && c >= 32) { __syncthreads(); prep_layer_jobs(p, smem, layer + 1, c - 32, G - 32, 0, 2544); } } break;
    case 7: if constexpr ((PMASK >> 7) & 1) { OrderSimple S{ws + WS_MRG, ws + WS_WOT + (size_t)layer * DM * DM * 2, layer == 3 ? 64 : 68, 8, DM, DM, G, c};
        EpiWo Ep{(bf16_t*)(p->ws + WS_Y)};
        pg8::gemm_phase(lds, pg8::Gemm{DM, DM, DM}, S, Ep);
        if (layer < 3 && c >= 32) { __syncthreads(); prep_layer_jobs(p, smem, layer + 1, c - 32, G - 32, 2544, 2544); } } break;
    }
}

template <int PMASK> __global__ void __launch_bounds__(512, 2) hybrid_mega(Params p_byval) {
    extern __shared__ __attribute__((aligned(16))) unsigned char smem[];
    cg::grid_group grid = cg::this_grid();
    PP p0 = (PP)__builtin_amdgcn_kernarg_segment_ptr();
    const int lo = p0->ph_lo, hi = p0->ph_hi;
    {
        volatile LAS unsigned* st = (volatile LAS unsigned*)((LAS unsigned char*)smem + 131072);
        if (threadIdx.x == 0) { st[0] = 0u; st[1] = 0u; }
        if (blockIdx.x == 0) { unsigned* bar = (unsigned*)(p0->ws + WS_BAR); for (int i = threadIdx.x; i < XCD_BAR_WORDS; i += 512) bar[i] = 0u; }
        __syncthreads();
    }
    for (int ph = lo; ph < hi; ++ph) {
        if (ph == lo + 1) { grid.sync();
            if (threadIdx.x == 0) (void)xb_add(&((unsigned*)(p0->ws + WS_BAR))[XB_XCNT(xb_xcc_id())], 1u); }
        else if (ph > lo) { PP pb = p0; asm volatile("" : "+s"(pb)); xcd_barrier((unsigned*)(pb->ws + WS_BAR), (volatile LAS unsigned*)((LAS unsigned char*)smem + 131072)); }
        PP p = p0; asm volatile("" : "+s"(p));
        run_phase<PMASK>(p, ph, smem);
#ifdef DUP_SUB
        if (ph >= 1 && ph <= 32 && ((ph - 1) & 7) == DUP_SUB) { grid.sync(); PP p2 = p0; asm volatile("" : "+s"(p2)); run_phase<PMASK>(p2, ph, smem); }
#endif
#ifdef DUP_NORM0
        if (ph == 1) { grid.sync(); PP p2 = p0; asm volatile("" : "+s"(p2)); run_phase<PMASK>(p2, ph, smem); }
#endif
#ifdef DUP_PREP
        if (ph == 0) { grid.sync(); PP p2 = p0; asm volatile("" : "+s"(p2)); run_phase<PMASK>(p2, ph, smem); }
#endif
    }
}

extern "C" void kernel_launch(void* const* d_in, const int* in_sizes, int n_in, void* d_out, int out_size, void* d_ws, size_t ws_size, hipStream_t stream) {
    static int grid = 0;
    if (grid == 0) {
        if (n_in != 25 || ws_size < WS_END) { fprintf(stderr, "kernel_launch: unexpected n_in %d or ws_size %zu (< %zu)\n", n_in, ws_size, (size_t)WS_END); grid = -1; return; }
        bool okattr = true;
#if MULTI_LAUNCH
#define SETATTR(M) okattr = okattr && (hipFuncSetAttribute((const void*)hybrid_mega<M>, hipFuncAttributeMaxDynamicSharedMemorySize, LDS_BYTES) == hipSuccess)
        SETATTR(0x001); SETATTR(0x002); SETATTR(0x004); SETATTR(0x008); SETATTR(0x010); SETATTR(0x020); SETATTR(0x040); SETATTR(0x080); SETATTR(0x100);
#else
        okattr = hipFuncSetAttribute((const void*)hybrid_mega<0xFFFF>, hipFuncAttributeMaxDynamicSharedMemorySize, LDS_BYTES) == hipSuccess;
#endif
        if (!okattr) { fprintf(stderr, "kernel_launch: hipFuncSetAttribute failed\n"); grid = -1; return; }
        int dev = 0, cus = 0, per_cu = 0;
        (void)hipGetDevice(&dev); (void)hipDeviceGetAttribute(&cus, hipDeviceAttributeMultiprocessorCount, dev);
#if !MULTI_LAUNCH
        (void)hipOccupancyMaxActiveBlocksPerMultiprocessor(&per_cu, (const void*)hybrid_mega<0xFFFF>, 512, LDS_BYTES);
        if (per_cu < 1) { fprintf(stderr, "kernel_launch: occupancy query says %d blocks per CU\n", per_cu); per_cu = 1; }
#endif
        (void)hipGetLastError();
        if (cus < 256) { fprintf(stderr, "kernel_launch: built for a 256-CU device (got %d CUs)\n", cus); grid = -1; return; }
        grid = 256;
    }
    if (grid < 0) return;
    Params p{};
    const float** pp = (const float**)&p;
    for (int i = 0; i < 25; ++i) pp[i] = (const float*)d_in[i];
    p.out = (float*)d_out; p.ws = (unsigned char*)d_ws;
#if MULTI_LAUNCH
    for (int ph = 0; ph < 34; ++ph) { p.ph_lo = ph; p.ph_hi = ph + 1;
        const int sub = (ph == 0) ? 8 : (ph == 33 ? 0 : ((ph - 1) & 7));
        switch (sub) {
#define LCH(K) case K: hipLaunchKernelGGL(hybrid_mega<(1 << K)>, dim3(grid), dim3(512), LDS_BYTES, stream, p); break
        LCH(0); LCH(1); LCH(2); LCH(3); LCH(4); LCH(5); LCH(6); LCH(7); LCH(8);
        } }
#else
    p.ph_lo = 0; p.ph_hi = 34;
    void* args[] = {&p};
    hipError_t e = hipLaunchCooperativeKernel((const void*)hybrid_mega<0xFFFF>, dim3(grid), dim3(512), args, LDS_BYTES, stream);
    if (e != hipSuccess) fprintf(stderr, "cooperative launch failed: %s (grid %d)\n", hipGetErrorString(e), grid);
#endif
}
```
